# Optimizing an MI355X kernel written in HIP

```python
import math
import jax, jax.numpy as jnp
from jax import lax
import numpy as np


D_MODEL = 1024
BATCH = 16
SEQ = 2048
DEPTH = 1

CHUNK = 64
Q_BLOCK = 128

A_HEADS = 4
A_HEAD_DIM = 128
A_WIDTH = A_HEADS * A_HEAD_DIM
A_KV_RANK = 128
IDX_HEADS = 8
IDX_DIM = 64
TOPK_MAX = 256

B_HEADS = 4
B_KEY_DIM = 128
B_VAL_DIM = 128
B_WIDTH = B_HEADS * B_VAL_DIM
B_FORGET = B_HEADS * B_KEY_DIM

D_MIX = A_WIDTH + B_WIDTH

REL_BUCKETS = 32
REL_MAX_DIST = 256

DEEPNORM_ALPHA = (2.0 * DEPTH) ** 0.25
DEEPNORM_BETA = (8.0 * DEPTH) ** -0.25
LN_EPS = 1e-5
RMS_EPS = 1e-6

_SPLITS = (
    ('a_q', A_WIDTH),
    ('a_ckv', A_KV_RANK),
    ('a_iq', IDX_HEADS * IDX_DIM),
    ('a_ik', IDX_DIM),
    ('a_iw', IDX_HEADS),
    ('a_gate', A_WIDTH),
    ('b_q', B_FORGET),
    ('b_f', B_FORGET),
    ('b_i', B_WIDTH),
    ('b_gate', B_WIDTH),
)
D_IN_PROJ = int(sum(n for _, n in _SPLITS))
SPLIT_POINTS = tuple(int(v) for v in np.cumsum([n for _, n in _SPLITS])[:-1])

kernel_name = 'hybrid_dsa_hgrn2_deepnorm_layer'


def _rms_norm(x, g):
    xf = x.astype(jnp.float32)
    y = xf * lax.rsqrt(jnp.mean(xf * xf, axis=-1, keepdims=True) + RMS_EPS)
    return (y * g.astype(jnp.float32)).astype(x.dtype)


def _layer_norm(x, g, b):
    xf = x.astype(jnp.float32)
    mu = jnp.mean(xf, axis=-1, keepdims=True)
    var = jnp.mean(jnp.square(xf - mu), axis=-1, keepdims=True)
    y = (xf - mu) * lax.rsqrt(var + LN_EPS) * g.astype(jnp.float32) + b.astype(jnp.float32)
    return y.astype(x.dtype)


def _t5_bucket(rel):
    nb = REL_BUCKETS // 2
    max_exact = nb // 2
    ret = jnp.where(rel > 0, nb, 0).astype(jnp.int32)
    n = jnp.abs(rel)
    nf = jnp.maximum(n, 1).astype(jnp.float32)
    large = max_exact + (jnp.log(nf / max_exact) / math.log(REL_MAX_DIST / max_exact)
                         * (nb - max_exact)).astype(jnp.int32)
    large = jnp.minimum(large, nb - 1)
    return ret + jnp.where(n < max_exact, n, large)


def _dsa_mixer(q, c, iq, ik, iw, w_uk, rel_bias):
    bsz, seq = q.shape[0], q.shape[1]
    k_sel = min(TOPK_MAX, seq // 4)
    n_blk = seq // Q_BLOCK
    q_lat = jnp.einsum('bshd,hdr->bshr', q, w_uk)
    scale = A_HEAD_DIM ** -0.5
    idx_scale = IDX_DIM ** -0.5
    w_scale = IDX_HEADS ** -0.5
    pos = jnp.arange(seq, dtype=jnp.int32)
    key_chunk = pos // CHUNK

    def blockify(t):
        return jnp.moveaxis(t.reshape(bsz, n_blk, Q_BLOCK, *t.shape[2:]), 1, 0)

    xs = (blockify(q_lat), blockify(iq), blockify(iw), pos.reshape(n_blk, Q_BLOCK))

    def one_block(args):
        ql, iqb, iwb, qpos = args
        q_chunk = qpos // CHUNK
        admissible = key_chunk[None, :] <= q_chunk[:, None]
        dots = jnp.einsum('bqhd,bsd->bqhs', iqb, ik) * idx_scale
        score = jnp.einsum('bqh,bqhs->bqs', iwb * w_scale, jax.nn.relu(dots))
        score = jnp.where(admissible[None], score.astype(jnp.float32), -jnp.inf)
        _, sel = lax.top_k(score, k_sel)
        valid = (sel // CHUNK) <= q_chunk[None, :, None]
        c_sel = jax.vmap(lambda cb, ib: cb[ib])(c, sel)
        bias = rel_bias[_t5_bucket(sel - qpos[None, :, None])]
        logits = (jnp.einsum('bqhr,bqkr->bqhk', ql, c_sel).astype(jnp.float32) * scale
                  + jnp.swapaxes(bias, -1, -2).astype(jnp.float32))
        logits = jnp.where(valid[:, :, None, :], logits, -jnp.inf)
        p = jax.nn.softmax(logits, axis=-1).astype(c.dtype)
        return jnp.einsum('bqhk,bqkr->bqhr', p, c_sel)

    o = lax.map(one_block, xs)
    return jnp.moveaxis(o, 0, 1).reshape(bsz, seq, A_HEADS, A_KV_RANK)


def _hgrn2_mixer(q, f_raw, v, lb):
    bsz, seq = q.shape[0], q.shape[1]
    n_chunk = seq // CHUNK
    q = jax.nn.silu(q.astype(jnp.float32))
    lbh = lb.reshape(B_HEADS, B_KEY_DIM).astype(jnp.float32)
    f = lbh + (1.0 - lbh) * jax.nn.sigmoid(f_raw.astype(jnp.float32))
    k = 1.0 - f
    log_f = jnp.log(f)

    def chunkify(t):
        return jnp.transpose(t.reshape(bsz, n_chunk, CHUNK, B_HEADS, t.shape[-1]), (1, 0, 3, 2, 4))

    qc, kc, vc = chunkify(q), chunkify(k), chunkify(v.astype(jnp.float32))
    bc = jnp.cumsum(chunkify(log_f), axis=3)
    causal = jnp.tril(jnp.ones((CHUNK, CHUNK), dtype=bool))

    def step(state, inp):
        qn, kn, vn, bn = inp
        diff = bn[:, :, :, None, :] - bn[:, :, None, :, :]
        decay = jnp.exp(jnp.where(causal[:, :, None], diff, -jnp.inf))
        scores = jnp.einsum('bhtk,bhsk,bhtsk->bhts', qn, kn, decay)
        o = (jnp.einsum('bhts,bhsv->bhtv', scores, vn)
             + jnp.einsum('bhtk,bhkv->bhtv', qn * jnp.exp(bn), state))
        b_last = bn[:, :, -1:, :]
        state = (jnp.exp(b_last[:, :, 0, :])[..., None] * state
                 + jnp.einsum('bhsk,bhsv->bhkv', kn * jnp.exp(b_last - bn), vn))
        return state, o

    s0 = jnp.zeros((bsz, B_HEADS, B_KEY_DIM, B_VAL_DIM), jnp.float32)
    _, o = lax.scan(step, s0, (qc, kc, vc, bc))
    return jnp.transpose(o, (1, 0, 3, 2, 4)).reshape(bsz, seq, B_HEADS, B_VAL_DIM)


def setup_inputs(seed: int = 0) -> dict:
    key = jax.random.key(seed)
    ks = jax.random.split(key, 12)
    x = jax.random.normal(ks[0], (BATCH, SEQ, D_MODEL), jnp.float32)
    col_scale = jnp.concatenate([
        jnp.full((n,), DEEPNORM_BETA if name == 'b_i' else 1.0, jnp.float32) for name, n in _SPLITS])
    w_in = jax.random.normal(ks[1], (DEPTH, D_MODEL, D_IN_PROJ), jnp.float32) * (D_MODEL ** -0.5) * col_scale
    w_uk = jax.random.normal(ks[2], (DEPTH, A_HEADS, A_HEAD_DIM, A_KV_RANK), jnp.float32) * (A_HEAD_DIM ** -0.5)
    w_uv = (jax.random.normal(ks[3], (DEPTH, A_HEADS, A_KV_RANK, A_HEAD_DIM), jnp.float32)
            * (A_KV_RANK ** -0.5) * DEEPNORM_BETA)
    kv_norm_g = 1.0 + 0.05 * jax.random.normal(ks[4], (DEPTH, A_KV_RANK), jnp.float32)
    rel_bias = 0.2 * jax.random.normal(ks[5], (REL_BUCKETS, A_HEADS), jnp.float32)
    lb_logits = 0.5 * jax.random.normal(ks[6], (DEPTH + 1, B_FORGET), jnp.float32)
    hgrn_norm_g = 1.0 + 0.05 * jax.random.normal(ks[7], (DEPTH, B_WIDTH), jnp.float32)
    w_o = jax.random.normal(ks[8], (DEPTH, D_MIX, D_MODEL), jnp.float32) * (D_MIX ** -0.5) * DEEPNORM_BETA
    ln_g = 1.0 + 0.05 * jax.random.normal(ks[9], (DEPTH, D_MODEL), jnp.float32)
    ln_b = 0.02 * jax.random.normal(ks[10], (DEPTH, D_MODEL), jnp.float32)
    return {'x': x, 'w_in': w_in, 'w_uk': w_uk, 'w_uv': w_uv, 'kv_norm_g': kv_norm_g,
            'rel_bias': rel_bias, 'lb_logits': lb_logits, 'hgrn_norm_g': hgrn_norm_g,
            'w_o': w_o, 'ln_g': ln_g, 'ln_b': ln_b}


def reference(x, w_in, w_uk, w_uv, kv_norm_g, rel_bias, lb_logits, hgrn_norm_g, w_o, ln_g, ln_b):
    bsz, seq, _ = x.shape
    lb_all = jnp.cumsum(jax.nn.softmax(lb_logits.astype(jnp.float32), axis=0), axis=0)
    for layer in range(DEPTH):
        h = jnp.einsum('bsd,dc->bsc', x, w_in[layer])
        a_q, a_ckv, a_iq, a_ik, a_iw, a_gate, b_q, b_f, b_i, b_gate = jnp.split(h, SPLIT_POINTS, axis=-1)

        c = _rms_norm(a_ckv, kv_norm_g[layer])
        o_lat = _dsa_mixer(a_q.reshape(bsz, seq, A_HEADS, A_HEAD_DIM), c,
                           a_iq.reshape(bsz, seq, IDX_HEADS, IDX_DIM), a_ik, a_iw,
                           w_uk[layer], rel_bias)
        o_a = jnp.einsum('bshr,hrv->bshv', o_lat, w_uv[layer]).reshape(bsz, seq, A_WIDTH)
        o_a = o_a * jax.nn.silu(a_gate)

        o_b = _hgrn2_mixer(b_q.reshape(bsz, seq, B_HEADS, B_KEY_DIM),
                           b_f.reshape(bsz, seq, B_HEADS, B_KEY_DIM),
                           b_i.reshape(bsz, seq, B_HEADS, B_VAL_DIM), lb_all[layer])
        o_b = _rms_norm(o_b, hgrn_norm_g[layer].reshape(B_HEADS, B_VAL_DIM)).reshape(bsz, seq, B_WIDTH)
        o_b = o_b.astype(x.dtype) * jax.nn.silu(b_gate)

        y = jnp.einsum('bsc,cd->bsd', jnp.concatenate([o_a.astype(x.dtype), o_b], axis=-1), w_o[layer])
        x = _layer_norm(DEEPNORM_ALPHA * x + y, ln_g[layer], ln_b[layer])
    return x
```

```cpp
#include <hip/hip_runtime.h>
#include <hip/hip_cooperative_groups.h>
#include <cstdio>
#include <cstdint>

constexpr int T_TOK = 32768, DM = 1024, SEQ = 2048, NBATCH = 16, NPROJ = 3840  , DIN = 3784;
constexpr float QSCALE = 0.08838834764831845f * 1.4426950408889634f;
constexpr float LOG2E = 1.4426950408889634f;
constexpr float IW_SCALE = 0.35355339059327373f * 0.125f;
constexpr float DN_ALPHA = 1.189207115002721f;
namespace pg8 {
#define PG8_LAS __attribute__((address_space(3)))
typedef unsigned short bf16_t;
typedef short bf16x8 __attribute__((ext_vector_type(8)));
typedef float f32x4 __attribute__((ext_vector_type(4)));
typedef unsigned u32x4 __attribute__((ext_vector_type(4)));
constexpr int BM = 256, BK = 64, HALF = 128, HTB = HALF * BK * 2  , STAGE_BYTES = 8 * HTB, NXCD = 8, WGM = 8;

__host__ __device__ __forceinline__ int lds_byte(int r, int c) { const int st = (r >> 4) * 2 + (c >> 5), rr = r & 15, cc = c & 31, ob = rr * 64 + cc * 2; return st * 1024 + (ob ^ (((ob >> 9) & 1) << 5)); }
__host__ __device__ __forceinline__ void stage_rc(int b, int& R, int& C) { const int st = b / 1024, sb = b % 1024, swz = sb ^ (((sb >> 9) & 1) << 5); R = (st >> 1) * 16 + swz / 64; C = (st & 1) * 32 + (swz % 64) / 2; }
__host__ __device__ __forceinline__ int perm32(int rho) { const int n = rho >> 4, i = rho & 15; return 8 * (i >> 2) + 4 * n + (i & 3); }

struct Unit { int pm, pn; };
struct Gemm { const bf16_t* A; const bf16_t* Bt; int M, N, K; };

struct StaticOrder {
    int nM, nN, nwg, G, c;
    __host__ __device__ void init(int M, int N, int G_, int c_) { nM = M / BM; nN = N / BM; nwg = nM * nN; G = G_; c = c_; }
    __host__ __device__ bool next(int i, Unit& u) const {
        const long L = (long)i * G + c; if (L >= nwg) return false;
        int wgid = (int)L; { const int q = nwg / NXCD, r = nwg % NXCD, xcd = wgid % NXCD, off = wgid / NXCD; wgid = (xcd < r ? xcd * (q + 1) : r * (q + 1) + (xcd - r) * q) + off; }
        const int nig = WGM * nN, gid = wgid / nig, fm = gid * WGM, gsz = (nM - fm) < WGM ? (nM - fm) : WGM;
        u.pm = fm + ((wgid % nig) % gsz); u.pn = (wgid % nig) / gsz; return true;
    }
    __device__ __forceinline__ void a_ready(const Unit&) const {}
    __device__ __forceinline__ void done(const Unit&) const {}
};

typedef float f32x2_t __attribute__((ext_vector_type(2)));
typedef __bf16 bf16x2_t __attribute__((ext_vector_type(2)));
typedef _Float16 f16x2_t __attribute__((ext_vector_type(2)));
__device__ __forceinline__ unsigned pkbf(float lo, float hi) { f32x2_t v = {lo, hi}; bf16x2_t b = __builtin_convertvector(v, bf16x2_t); return __builtin_bit_cast(unsigned, b); }
__device__ __forceinline__ unsigned pkh(float lo, float hi) { f32x2_t v = {lo, hi}; f16x2_t b = __builtin_convertvector(v, f16x2_t); return __builtin_bit_cast(unsigned, b); }
__device__ __forceinline__ float sigm(float x) { return __builtin_amdgcn_rcpf(1.0f + __builtin_amdgcn_exp2f(-1.4426950408889634f * x)); }
__device__ __forceinline__ float silu(float x) { return x * sigm(x); }

struct EpiInProj {
    static constexpr bool PERM = true, AFTER_DRAIN = false;
    unsigned short* base16; float* misc; const float* lb; size_t arr_stride;
    template <int ACT> __device__ __forceinline__ void store16(const f32x4 (&acc)[2][2][4][2], unsigned short* dst, int row0, const f32x4 (&lbv)[2][2]) const {
#pragma unroll
        for (int ai = 0; ai < 2; ++ai)
#pragma unroll
            for (int m = 0; m < 4; ++m) { unsigned short* rowp = dst + (size_t)(row0 + ai * HALF + m * 16) * 512;
#pragma unroll
                for (int bj = 0; bj < 2; ++bj) { f32x4 v0 = acc[ai][bj][m][0], v1 = acc[ai][bj][m][1]; u32x4 w;
                    if (ACT == 1) {
#pragma unroll
                        for (int e = 0; e < 4; ++e) { v0[e] = silu(v0[e]); v1[e] = silu(v1[e]); } }
                    if (ACT == 2) {
#pragma unroll
                        for (int e = 0; e < 4; ++e) { const float l0 = lbv[bj][0][e], l1 = lbv[bj][1][e];
                            v0[e] = 0.6931471805599453f * __builtin_amdgcn_logf(l0 + (1.0f - l0) * sigm(v0[e]));
                            v1[e] = 0.6931471805599453f * __builtin_amdgcn_logf(l1 + (1.0f - l1) * sigm(v1[e])); }
                        w.x = pkh(v0[0], v0[1]); w.y = pkh(v0[2], v0[3]); w.z = pkh(v1[0], v1[1]); w.w = pkh(v1[2], v1[3]);
                    } else { w.x = pkbf(v0[0], v0[1]); w.y = pkbf(v0[2], v0[3]); w.z = pkbf(v1[0], v1[1]); w.w = pkbf(v1[2], v1[3]); }
                    *(u32x4*)(rowp + bj * HALF) = w; } }
    }
    __device__ __forceinline__ void operator()(const f32x4 (&acc)[2][2][4][2], const Unit& u, int wr, int wc, int fr, int fq) const {
        const int row0 = u.pm * BM + wr * 64 + fr, cb = wc * 32 + 8 * fq;
        if (u.pn == 14) {
#pragma unroll
            for (int ai = 0; ai < 2; ++ai)
#pragma unroll
                for (int m = 0; m < 4; ++m) { float* rowp = misc + (size_t)(row0 + ai * HALF + m * 16) * 256 + cb;
#pragma unroll
                    for (int bj = 0; bj < 2; ++bj) { *(f32x4*)(rowp + bj * HALF) = acc[ai][bj][m][0]; *(f32x4*)(rowp + bj * HALF + 4) = acc[ai][bj][m][1]; } }
            return;
        }
        const int type = u.pn >> 1, ch = (u.pn & 1) * 256 + cb;
        unsigned short* dst = base16 + (size_t)type * arr_stride + ch;
        f32x4 lbv[2][2];
#pragma unroll
        for (int bj = 0; bj < 2; ++bj)
#pragma unroll
            for (int n = 0; n < 2; ++n) lbv[bj][n] = (type == 4) ? *(const f32x4*)(lb + ch + bj * HALF + 4 * n) : (f32x4){0.f, 0.f, 0.f, 0.f};
        if (type == 4) store16<2>(acc, dst, row0, lbv);
        else if (type == 2 || type == 3 || type == 6) store16<1>(acc, dst, row0, lbv);
        else store16<0>(acc, dst, row0, lbv);
    }
};
struct EpiOutRes {
    static constexpr bool PERM = false, AFTER_DRAIN = false;
    const float* x; float* out; float alpha;
    __device__ __forceinline__ void operator()(const f32x4 (&acc)[2][2][4][2], const Unit& u, int wr, int wc, int fr, int fq) const {
        const int row0 = u.pm * BM + wr * 64 + fr, col0 = u.pn * BM + wc * 32 + 4 * fq;
#pragma unroll
        for (int ai = 0; ai < 2; ++ai)
#pragma unroll
            for (int m = 0; m < 4; ++m) { const size_t off = (size_t)(row0 + ai * HALF + m * 16) * 1024 + col0;
#pragma unroll
                for (int bj = 0; bj < 2; ++bj)
#pragma unroll
                    for (int n = 0; n < 2; ++n) { const f32x4 xv = *(const f32x4*)(x + off + bj * HALF + n * 16); *(f32x4*)(out + off + bj * HALF + n * 16) = xv * alpha + acc[ai][bj][m][n]; } }
    }
};

template <class Epi, class Sched, bool ALIGN_EPI = false, bool SP2 = false>
__device__ __forceinline__ void gemm_phase(PG8_LAS unsigned char* lds, const Gemm g, const Sched& S, const Epi& E) {
    const int tid = threadIdx.x, wid = __builtin_amdgcn_readfirstlane(tid >> 6), lane = tid & 63, wr = wid >> 2, wc = wid & 3, fr = lane & 15, fq = lane >> 4;
    const int K = g.K, nt = K / BK;
    unsigned voffA[2], voffB[2];
#pragma unroll
    for (int i = 0; i < 2; ++i) { int R, C; stage_rc(tid * 16 + i * 8192, R, C); const int Rb = Epi::PERM ? ((R & ~31) + perm32(R & 31)) : R;
        voffA[i] = (unsigned)(R * K + C) * 2u; voffB[i] = (unsigned)(Rb * K + C) * 2u; }
    const size_t kstep = (size_t)(BK * 2);
    const size_t hstep = (size_t)HALF * K * 2;
    const size_t tstep = 2 * hstep;
    const unsigned ldsw = (unsigned)wid * 1024u;
    const int aoff = lds_byte(wr * 64 + fr, fq * 8), boff = lds_byte(wc * 32 + fr, fq * 8);
#define PG8_SA(b, h) (((b) * 2 + (h)) * HTB)
#define PG8_SB(b, h) ((4 + (b) * 2 + (h)) * HTB)
#define PG8_STAGE(bufoff, gbase, voff) do { _Pragma("unroll") for (int _i = 0; _i < 2; ++_i) \
        __builtin_amdgcn_global_load_lds((const unsigned*)((const char*)(gbase) + (voff)[_i]), (PG8_LAS unsigned*)(lds + (bufoff) + ldsw + _i * 8192), 16, 0, 0); } while (0)
#define PG8_LDA(dst, b, h) do { _Pragma("unroll") for (int m = 0; m < 4; ++m) _Pragma("unroll") for (int k = 0; k < 2; ++k) dst[m][k] = *(const PG8_LAS bf16x8*)(lds + PG8_SA(b, h) + aoff + m * 2048 + k * 1024); } while (0)
#define PG8_LDB(dst, b, h) do { _Pragma("unroll") for (int n = 0; n < 2; ++n) _Pragma("unroll") for (int k = 0; k < 2; ++k) dst[n][k] = *(const PG8_LAS bf16x8*)(lds + PG8_SB(b, h) + boff + n * 2048 + k * 1024); } while (0)
#define PG8_MMA(ai, bj, At, Bt) do { __builtin_amdgcn_s_setprio(1); _Pragma("unroll") for (int m = 0; m < 4; ++m) _Pragma("unroll") for (int n = 0; n < 2; ++n) _Pragma("unroll") for (int k = 0; k < 2; ++k) \
        acc[ai][bj][m][n] = __builtin_amdgcn_mfma_f32_16x16x32_bf16(Bt[n][k], At[m][k], acc[ai][bj][m][n], 0, 0, 0); __builtin_amdgcn_s_setprio(0); } while (0)
#define PG8_WAIT_V(n) asm volatile("s_waitcnt vmcnt(" #n ")" ::: "memory")
#define PG8_WAIT_L(n) asm volatile("s_waitcnt lgkmcnt(" #n ")" ::: "memory")
#define PG8_BAR __builtin_amdgcn_s_barrier()
#define PG8_SCHED __builtin_amdgcn_sched_barrier(0)
    Unit cur, nxt; int ui = 0;
    if (!S.next(0, cur)) return;
    f32x4 acc[2][2][4][2];
#pragma unroll
    for (int a = 0; a < 2; ++a)
#pragma unroll
        for (int b = 0; b < 2; ++b)
#pragma unroll
            for (int m = 0; m < 4; ++m)
#pragma unroll
                for (int n = 0; n < 2; ++n) acc[a][b][m][n] = (f32x4){0.f, 0.f, 0.f, 0.f};
    bf16x8 At[4][2], B0[2][2], B1[2][2];
    const char* cA = (const char*)g.A + (size_t)cur.pm * tstep; const char* cB = (const char*)g.Bt + (size_t)cur.pn * tstep;
    S.a_ready(cur);
    if constexpr (SP2) {
        PG8_STAGE(PG8_SB(0, 0), cB, voffB); PG8_STAGE(PG8_SB(0, 1), cB + hstep, voffB); PG8_STAGE(PG8_SA(0, 0), cA, voffA); PG8_STAGE(PG8_SA(0, 1), cA + hstep, voffA);
        if (wr == 1) PG8_BAR;
        PG8_WAIT_V(2); PG8_BAR;
        PG8_STAGE(PG8_SB(1, 0), cB + kstep, voffB); PG8_STAGE(PG8_SA(1, 0), cA + kstep, voffA); PG8_STAGE(PG8_SB(1, 1), cB + hstep + kstep, voffB);
        PG8_WAIT_V(6); PG8_BAR;
    } else {
        PG8_STAGE(PG8_SB(0, 0), cB, voffB); PG8_STAGE(PG8_SA(0, 0), cA, voffA); PG8_STAGE(PG8_SB(0, 1), cB + hstep, voffB); PG8_STAGE(PG8_SA(0, 1), cA + hstep, voffA);
        if (wr == 1) PG8_BAR;
        PG8_WAIT_V(4); PG8_BAR;
        PG8_STAGE(PG8_SB(1, 0), cB + kstep, voffB); PG8_STAGE(PG8_SA(1, 0), cA + kstep, voffA); PG8_STAGE(PG8_SB(1, 1), cB + hstep + kstep, voffB);
        PG8_WAIT_V(6); PG8_BAR;
    }
    for (;;) {
        const bool has_next = S.next(ui + 1, nxt);
        const char* nA = has_next ? (const char*)g.A + (size_t)nxt.pm * tstep : cA; const char* nB = has_next ? (const char*)g.Bt + (size_t)nxt.pn * tstep : cB;
        for (int t = 0; t < nt; t += 2) {
            const bool last = (t == nt - 2);
            const char* a1 = cA + (size_t)(t + 1) * kstep;
            const char* a2 = last ? nA : cA + (size_t)(t + 2) * kstep; const char* b2 = last ? nB : cB + (size_t)(t + 2) * kstep;
            const char* a3 = a2 + kstep; const char* b3 = b2 + kstep;
            if (last && has_next) S.a_ready(nxt);
            if constexpr (SP2) {
            PG8_LDB(B0, 0, 0); PG8_LDB(B1, 0, 1); PG8_SCHED; PG8_LDA(At, 0, 0); PG8_STAGE(PG8_SA(1, 1), a1 + hstep, voffA);
            PG8_WAIT_V(8); PG8_WAIT_L(0); PG8_BAR; PG8_MMA(0, 0, At, B0); PG8_MMA(0, 1, At, B1); PG8_BAR; PG8_SCHED;
            PG8_LDA(At, 0, 1); PG8_STAGE(PG8_SB(0, 0), b2, voffB); PG8_STAGE(PG8_SB(0, 1), b2 + hstep, voffB); PG8_STAGE(PG8_SA(0, 0), a2, voffA);
            PG8_WAIT_V(8); PG8_WAIT_L(0); PG8_BAR; PG8_MMA(1, 0, At, B0); PG8_MMA(1, 1, At, B1); PG8_BAR; PG8_SCHED;
            PG8_LDB(B0, 1, 0); PG8_LDB(B1, 1, 1); PG8_SCHED; PG8_LDA(At, 1, 0); PG8_STAGE(PG8_SA(0, 1), a2 + hstep, voffA);
            PG8_WAIT_V(8); PG8_WAIT_L(0); PG8_BAR; PG8_MMA(0, 0, At, B0); PG8_MMA(0, 1, At, B1); PG8_BAR; PG8_SCHED;
            PG8_LDA(At, 1, 1); PG8_STAGE(PG8_SB(1, 0), b3, voffB); PG8_STAGE(PG8_SB(1, 1), b3 + hstep, voffB); PG8_STAGE(PG8_SA(1, 0), a3, voffA);
            PG8_WAIT_V(8); PG8_WAIT_L(0); PG8_BAR; PG8_MMA(1, 0, At, B0); PG8_MMA(1, 1, At, B1); PG8_BAR; PG8_SCHED;
            } else {
            PG8_LDB(B0, 0, 0); PG8_SCHED; PG8_LDA(At, 0, 0); PG8_STAGE(PG8_SA(1, 1), a1 + hstep, voffA);
            PG8_WAIT_L(8); PG8_BAR; PG8_WAIT_L(0); PG8_MMA(0, 0, At, B0); PG8_BAR; PG8_SCHED;
            PG8_LDB(B1, 0, 1); PG8_STAGE(PG8_SB(0, 0), b2, voffB);
            PG8_BAR; PG8_WAIT_L(0); PG8_MMA(0, 1, At, B1); PG8_BAR;
            PG8_LDA(At, 0, 1); PG8_STAGE(PG8_SA(0, 0), a2, voffA);
            PG8_BAR; PG8_WAIT_L(0); PG8_MMA(1, 0, At, B0); PG8_BAR; PG8_SCHED;
            PG8_STAGE(PG8_SB(0, 1), b2 + hstep, voffB);
            PG8_WAIT_V(6); PG8_BAR; PG8_MMA(1, 1, At, B1); PG8_BAR;
            PG8_LDB(B0, 1, 0); PG8_SCHED; PG8_LDA(At, 1, 0); PG8_STAGE(PG8_SA(0, 1), a2 + hstep, voffA);
            PG8_WAIT_L(8); PG8_BAR; PG8_WAIT_L(0); PG8_MMA(0, 0, At, B0); PG8_BAR; PG8_SCHED;
            PG8_LDB(B1, 1, 1); PG8_STAGE(PG8_SB(1, 0), b3, voffB);
            PG8_BAR; PG8_WAIT_L(0); PG8_MMA(0, 1, At, B1); PG8_BAR;
            PG8_LDA(At, 1, 1); PG8_STAGE(PG8_SA(1, 0), a3, voffA);
            PG8_BAR; PG8_WAIT_L(0); PG8_MMA(1, 0, At, B0); PG8_BAR; PG8_SCHED;
            PG8_STAGE(PG8_SB(1, 1), b3 + hstep, voffB);
            PG8_WAIT_V(6); PG8_BAR; PG8_MMA(1, 1, At, B1); PG8_BAR;
            }
        }
        if constexpr (ALIGN_EPI) { if (wr == 0) PG8_BAR; }
        if constexpr (!Epi::AFTER_DRAIN) { E(acc, cur, wr, wc, fr, fq); S.done(cur); }
        if (!has_next) break;
#pragma unroll
        for (int a = 0; a < 2; ++a)
#pragma unroll
            for (int b = 0; b < 2; ++b)
#pragma unroll
                for (int m = 0; m < 4; ++m)
#pragma unroll
                    for (int n = 0; n < 2; ++n) acc[a][b][m][n] = (f32x4){0.f, 0.f, 0.f, 0.f};
        cur = nxt; cA = nA; cB = nB; ++ui;
        if constexpr (ALIGN_EPI) { if (wr == 1) PG8_BAR; }
    }
    PG8_WAIT_V(0);
    if constexpr (!ALIGN_EPI) { if (wr == 0) PG8_BAR; }
    PG8_BAR;
    if constexpr (Epi::AFTER_DRAIN) { E.fused(acc, cur, wr, wc, fr, fq, lds, wid, lane); S.done(cur); }
#undef PG8_SA
#undef PG8_SB
#undef PG8_STAGE
#undef PG8_LDA
#undef PG8_LDB
#undef PG8_MMA
#undef PG8_WAIT_V
#undef PG8_WAIT_L
#undef PG8_BAR
#undef PG8_SCHED
}
}

constexpr size_t MiB = 1u << 20;
constexpr size_t WS_CTL = 0;
constexpr size_t WS_WTIN = 2 * MiB;
constexpr size_t WS_WTO = 10 * MiB;
constexpr size_t WS_LB = 12 * MiB;
constexpr size_t WS_XB = 16 * MiB;
constexpr size_t WS_MIX = 16 * MiB;
constexpr size_t WS_H16 = 80 * MiB;
constexpr size_t H16_STRIDE = (size_t)T_TOK * 512;
constexpr size_t WS_MISC = 304 * MiB;
constexpr size_t WS_CN = 336 * MiB;
constexpr size_t WS_IKB = 344 * MiB;
constexpr size_t WS_IWF = 348 * MiB;
constexpr size_t WS_OB = 352 * MiB;
constexpr size_t WS_OLAT = 416 * MiB;
constexpr size_t WS_END = 480 * MiB;

typedef unsigned short bf16;
typedef unsigned v4u __attribute__((ext_vector_type(4)));
typedef float f32x4 __attribute__((ext_vector_type(4)));
__device__ __forceinline__ float bf2f(unsigned short b) { return __uint_as_float((unsigned)b << 16); }
__device__ __forceinline__ float h2f(unsigned short b) { return (float)__builtin_bit_cast(_Float16, b); }
__device__ __forceinline__ float wave_sum(float v) {
#pragma unroll
    for (int o = 1; o < 64; o <<= 1) v += __shfl_xor(v, o);
    return v;
}
__device__ __forceinline__ float wave_max(float v) {
#pragma unroll
    for (int o = 1; o < 64; o <<= 1) v = fmaxf(v, __shfl_xor(v, o));
    return v;
}

struct Args { const float* in[11]; float* out; unsigned char* ws; };

__device__ __forceinline__ int src_col(int n) {
    if (n < 1024) return 640 + (n - 512);
    if (n < 1536) return 1224 + (n - 1024);
    if (n < 2048) return 1736 + (n - 1536);
    if (n < 2560) return 2248 + (n - 2048);
    if (n < 3072) return 2760 + (n - 2560);
    if (n < 3584) return 3272 + (n - 3072);
    if (n < 3712) return 512 + (n - 3584);
    if (n < 3776) return 1152 + (n - 3712);
    return 1216 + (n - 3776);
}

__device__ __forceinline__ void p0_prep(const Args& a, long gtid, long gsize) {
    const float* x = a.in[0]; const float* w_in = a.in[1]; const float* w_uk = a.in[2]; const float* lbl = a.in[6]; const float* w_o = a.in[8];
    bf16* XB = (bf16*)(a.ws + WS_XB); bf16* WTIN = (bf16*)(a.ws + WS_WTIN); bf16* WTO = (bf16*)(a.ws + WS_WTO); float* LB = (float*)(a.ws + WS_LB);
    constexpr long I_W = (long)NPROJ * 128, I_O = 1024L * 128, I_LB = 512, I_X = (long)T_TOK * DM / 8;
    for (long i = gtid; i < I_W + I_O + I_LB + I_X; i += gsize) {
        if (i < I_W) {
            const int n = (int)(i % NPROJ), k0 = (int)(i / NPROJ) * 8; float v[8];
            if (n < 512) {
                const int h = n >> 7, r = n & 127;
#pragma unroll
                for (int j = 0; j < 8; ++j) v[j] = 0.f;
                for (int d = 0; d < 128; ++d) { const float wu = w_uk[(h * 128 + d) * 128 + r];
#pragma unroll
                    for (int j = 0; j < 8; ++j) v[j] += w_in[(size_t)(k0 + j) * DIN + h * 128 + d] * wu; }
#pragma unroll
                for (int j = 0; j < 8; ++j) v[j] *= QSCALE;
            } else if (n < DIN) { const int sc = src_col(n);
#pragma unroll
                for (int j = 0; j < 8; ++j) v[j] = w_in[(size_t)(k0 + j) * DIN + sc];
            } else {
#pragma unroll
                for (int j = 0; j < 8; ++j) v[j] = 0.f;
            }
            v4u o; o.x = pg8::pkbf(v[0], v[1]); o.y = pg8::pkbf(v[2], v[3]); o.z = pg8::pkbf(v[4], v[5]); o.w = pg8::pkbf(v[6], v[7]);
            *(v4u*)(WTIN + (size_t)n * DM + k0) = o;
        } else if (i < I_W + I_O) {
            const long ii = i - I_W; const int n = (int)(ii % 1024), k0 = (int)(ii / 1024) * 8; float v[8];
#pragma unroll
            for (int j = 0; j < 8; ++j) v[j] = w_o[(size_t)(k0 + j) * 1024 + n];
            v4u o; o.x = pg8::pkbf(v[0], v[1]); o.y = pg8::pkbf(v[2], v[3]); o.z = pg8::pkbf(v[4], v[5]); o.w = pg8::pkbf(v[6], v[7]);
            *(v4u*)(WTO + (size_t)n * 1024 + k0) = o;
        } else if (i < I_W + I_O + I_LB) {
            const int c = (int)(i - I_W - I_O);
            LB[c] = 1.0f / (1.0f + expf(lbl[512 + c] - lbl[c]));
        } else {
            const long ii = i - I_W - I_O - I_LB;
            const f32x4 p = ((const f32x4*)x)[2 * ii], q = ((const f32x4*)x)[2 * ii + 1];
            v4u o; o.x = pg8::pkbf(p[0], p[1]); o.y = pg8::pkbf(p[2], p[3]); o.z = pg8::pkbf(q[0], q[1]); o.w = pg8::pkbf(q[2], q[3]);
            ((v4u*)XB)[ii] = o;
        }
    }
}
__global__ void __launch_bounds__(256) k_prep(Args a) { p0_prep(a, (long)blockIdx.x * blockDim.x + threadIdx.x, (long)gridDim.x * blockDim.x); }

__global__ void __launch_bounds__(512, 2) k_gemm_in(Args a) {
    extern __shared__ __attribute__((aligned(16))) unsigned char lds[];
    pg8::Gemm g{(const pg8::bf16_t*)(a.ws + WS_XB), (const pg8::bf16_t*)(a.ws + WS_WTIN), T_TOK, NPROJ, DM};
    pg8::StaticOrder S; S.init(T_TOK, NPROJ, (int)gridDim.x, (int)blockIdx.x);
    pg8::EpiInProj E{(unsigned short*)(a.ws + WS_H16), (float*)(a.ws + WS_MISC), (const float*)(a.ws + WS_LB), H16_STRIDE};
    pg8::gemm_phase<pg8::EpiInProj, pg8::StaticOrder, true, true>((PG8_LAS unsigned char*)lds, g, S, E);
}
__global__ void __launch_bounds__(512, 2) k_gemm_out(Args a) {
    extern __shared__ __attribute__((aligned(16))) unsigned char lds[];
    pg8::Gemm g{(const pg8::bf16_t*)(a.ws + WS_MIX), (const pg8::bf16_t*)(a.ws + WS_WTO), T_TOK, DM, DM};
    pg8::StaticOrder S; S.init(T_TOK, DM, (int)gridDim.x, (int)blockIdx.x);
    pg8::EpiOutRes E{a.in[0], a.out, DN_ALPHA};
    pg8::gemm_phase<pg8::EpiOutRes, pg8::StaticOrder, true, true>((PG8_LAS unsigned char*)lds, g, S, E);
}

__global__ void __launch_bounds__(256) k_post(Args a) {
    const float* misc = (const float*)(a.ws + WS_MISC); const float* kvg = a.in[4];
    bf16* CN = (bf16*)(a.ws + WS_CN); bf16* IKB = (bf16*)(a.ws + WS_IKB); float* IWF = (float*)(a.ws + WS_IWF);
    const int lane = threadIdx.x & 63, gw = (blockIdx.x * blockDim.x + threadIdx.x) >> 6, ngw = (gridDim.x * blockDim.x) >> 6;
    for (int t = gw; t < T_TOK; t += ngw) {
        const float* row = misc + (size_t)t * 256;
        const float c0 = row[2 * lane], c1 = row[2 * lane + 1];
        const float ms = wave_sum(c0 * c0 + c1 * c1) * (1.0f / 128.0f);
        const float rs = 1.0f / sqrtf(ms + 1e-6f);
        ((unsigned*)CN)[(size_t)t * 64 + lane] = pg8::pkbf(c0 * rs * kvg[2 * lane], c1 * rs * kvg[2 * lane + 1]);
        const float k0 = row[128 + lane]; const float k1 = __shfl_xor(k0, 1);
        if ((lane & 1) == 0) ((unsigned*)IKB)[(size_t)t * 32 + (lane >> 1)] = pg8::pkbf(k0, k1);
        if (lane < 8) IWF[(size_t)t * 8 + lane] = row[192 + lane] * IW_SCALE;
    }
}

__global__ void __launch_bounds__(128) k_hgrn_naive(Args a) {
    const bf16* BQ = (const bf16*)(a.ws + WS_H16) + 3 * H16_STRIDE; const bf16* BF = (const bf16*)(a.ws + WS_H16) + 4 * H16_STRIDE; const bf16* BI = (const bf16*)(a.ws + WS_H16) + 5 * H16_STRIDE;
    float* OB = (float*)(a.ws + WS_OB);
    __shared__ float qs[8][128], fs[8][128];
    const int b = blockIdx.x >> 2, h = blockIdx.x & 3, v = threadIdx.x;
    float st[128];
#pragma unroll
    for (int k = 0; k < 128; ++k) st[k] = 0.f;
    for (int t0 = 0; t0 < SEQ; t0 += 8) {
        __syncthreads();
#pragma unroll
        for (int tt = 0; tt < 8; ++tt) { const size_t off = (size_t)(b * SEQ + t0 + tt) * 512 + h * 128 + v; qs[tt][v] = bf2f(BQ[off]); fs[tt][v] = __expf(h2f(BF[off])); }
        __syncthreads();
#pragma unroll 1
        for (int tt = 0; tt < 8; ++tt) {
            const size_t off = (size_t)(b * SEQ + t0 + tt) * 512 + h * 128 + v;
            const float vv = bf2f(BI[off]); float o = 0.f;
#pragma unroll
            for (int k = 0; k < 128; ++k) { const float f = fs[tt][k]; st[k] = f * st[k] + (1.0f - f) * vv; o += qs[tt][k] * st[k]; }
            OB[off] = o;
        }
    }
}

__device__ __forceinline__ int t5_bucket(int rel) {
    const int n = rel < 0 ? -rel : rel; int bk;
    if (n < 8) bk = n; else bk = 8 + (n >= 13) + (n >= 20) + (n >= 30) + (n >= 46) + (n >= 70) + (n >= 108) + (n >= 166);
    return bk + (rel > 0 ? 16 : 0);
}
__device__ __forceinline__ int fkey(float f) { const int b = __float_as_int(f); return b ^ ((b >> 31) & 0x7fffffff); }
__global__ void __launch_bounds__(256) k_dsa_naive(Args a) {
    const bf16* QL = (const bf16*)(a.ws + WS_H16); const bf16* IQ = (const bf16*)(a.ws + WS_H16) + 1 * H16_STRIDE;
    const bf16* CN = (const bf16*)(a.ws + WS_CN); const bf16* IKB = (const bf16*)(a.ws + WS_IKB); const float* IWF = (const float*)(a.ws + WS_IWF);
    const float* rel_bias = a.in[5]; float* OLAT = (float*)(a.ws + WS_OLAT);
    __shared__ float sc[2048]; __shared__ float iqs[512]; __shared__ float qls[512]; __shared__ float wsh[8];
    __shared__ int sel[256]; __shared__ float lg[4][256]; __shared__ int cnt_s; __shared__ int scan_s[256];
    const int t = blockIdx.x, b = t >> 11, s = t & 2047, c = s >> 6, nk = 64 * (c + 1), tid = threadIdx.x;
    for (int i = tid; i < 512; i += 256) { iqs[i] = bf2f(IQ[(size_t)t * 512 + i]); qls[i] = bf2f(QL[(size_t)t * 512 + i]); }
    if (tid < 8) wsh[tid] = IWF[(size_t)t * 8 + tid];
    __syncthreads();
    int nsel;
    if (nk <= 256) {
        if (tid < nk) sel[tid] = tid;
        nsel = nk;
    } else {
        for (int key = tid; key < nk; key += 256) {
            const v4u* kp = (const v4u*)(IKB + (size_t)(b * SEQ + key) * 64); float kv[64];
#pragma unroll
            for (int q = 0; q < 8; ++q) { const v4u w = kp[q];
                kv[8 * q + 0] = __uint_as_float(w.x << 16); kv[8 * q + 1] = __uint_as_float(w.x & 0xffff0000u); kv[8 * q + 2] = __uint_as_float(w.y << 16); kv[8 * q + 3] = __uint_as_float(w.y & 0xffff0000u);
                kv[8 * q + 4] = __uint_as_float(w.z << 16); kv[8 * q + 5] = __uint_as_float(w.z & 0xffff0000u); kv[8 * q + 6] = __uint_as_float(w.w << 16); kv[8 * q + 7] = __uint_as_float(w.w & 0xffff0000u); }
            float score = 0.f;
#pragma unroll 1
            for (int h = 0; h < 8; ++h) { float d = 0.f;
#pragma unroll
                for (int e = 0; e < 64; ++e) d += iqs[h * 64 + e] * kv[e];
                score += wsh[h] * fmaxf(d, 0.f); }
            sc[key] = score + 0.0f;
        }
        __syncthreads();
        int u[8];
#pragma unroll
        for (int j = 0; j < 8; ++j) { const int key = tid * 8 + j; u[j] = key < nk ? fkey(sc[key]) : (int)0x80000000; }
        long long lo = (long long)(int)0x80000000, hi = 0x7fffffffLL; int thr = 0; bool exact = false; int cnt_hi = 0;
        for (;;) {
            if (hi - lo <= 1) break;
            const int mid = (int)(lo + (hi - lo) / 2);
            if (tid == 0) cnt_s = 0;
            __syncthreads();
            int lc = 0;
#pragma unroll
            for (int j = 0; j < 8; ++j) lc += (u[j] > mid) ? 1 : 0;
            if (lc) atomicAdd(&cnt_s, lc);
            __syncthreads();
            const int cnt = cnt_s;
            __syncthreads();
            if (cnt == 256) { thr = mid; exact = true; break; }
            if (cnt > 256) lo = mid; else { hi = mid; cnt_hi = cnt; }
        }
        int flag[8]; int lc = 0;
        if (exact) {
#pragma unroll
            for (int j = 0; j < 8; ++j) { flag[j] = (u[j] > thr) ? 1 : 0; lc += flag[j]; }
        } else {
            const int vk = (int)hi;
            int eq = 0;
#pragma unroll
            for (int j = 0; j < 8; ++j) eq += (u[j] == vk) ? 1 : 0;
            scan_s[tid] = eq; __syncthreads();
            int before = 0; for (int i = 0; i < tid; ++i) before += scan_s[i];
            __syncthreads();
            const int need = 256 - cnt_hi;
#pragma unroll
            for (int j = 0; j < 8; ++j) { int f = (u[j] > vk) ? 1 : 0; if (u[j] == vk) { if (before < need) f = 1; ++before; } flag[j] = f; lc += f; }
        }
        scan_s[tid] = lc; __syncthreads();
        int pos = 0; for (int i = 0; i < tid; ++i) pos += scan_s[i];
#pragma unroll
        for (int j = 0; j < 8; ++j) if (flag[j]) { if (pos < 256) sel[pos] = tid * 8 + j; ++pos; }
        nsel = 256;
    }
    __syncthreads();
    if (tid < nsel) {
        const int key = sel[tid]; const v4u* cp = (const v4u*)(CN + (size_t)(b * SEQ + key) * 128);
        float d0 = 0.f, d1 = 0.f, d2 = 0.f, d3 = 0.f;
#pragma unroll 2
        for (int q = 0; q < 16; ++q) { const v4u w = cp[q]; float cv[8];
            cv[0] = __uint_as_float(w.x << 16); cv[1] = __uint_as_float(w.x & 0xffff0000u); cv[2] = __uint_as_float(w.y << 16); cv[3] = __uint_as_float(w.y & 0xffff0000u);
            cv[4] = __uint_as_float(w.z << 16); cv[5] = __uint_as_float(w.z & 0xffff0000u); cv[6] = __uint_as_float(w.w << 16); cv[7] = __uint_as_float(w.w & 0xffff0000u);
#pragma unroll
            for (int e = 0; e < 8; ++e) { d0 += qls[8 * q + e] * cv[e]; d1 += qls[128 + 8 * q + e] * cv[e]; d2 += qls[256 + 8 * q + e] * cv[e]; d3 += qls[384 + 8 * q + e] * cv[e]; } }
        const int bk = t5_bucket(key - s);
        lg[0][tid] = d0 + LOG2E * rel_bias[bk * 4 + 0]; lg[1][tid] = d1 + LOG2E * rel_bias[bk * 4 + 1]; lg[2][tid] = d2 + LOG2E * rel_bias[bk * 4 + 2]; lg[3][tid] = d3 + LOG2E * rel_bias[bk * 4 + 3];
    }
    __syncthreads();
    { const int h = tid >> 6, lane = tid & 63; float v[4]; float m = -INFINITY;
#pragma unroll
      for (int j = 0; j < 4; ++j) { const int i = lane + 64 * j; v[j] = i < nsel ? lg[h][i] : -INFINITY; m = fmaxf(m, v[j]); }
      m = wave_max(m); float sum = 0.f;
#pragma unroll
      for (int j = 0; j < 4; ++j) { v[j] = exp2f(v[j] - m); sum += v[j]; }
      sum = wave_sum(sum); const float inv = 1.0f / sum;
#pragma unroll
      for (int j = 0; j < 4; ++j) { const int i = lane + 64 * j; if (i < nsel) lg[h][i] = v[j] * inv; } }
    __syncthreads();
    { const int h = tid >> 6, r0 = (tid & 63) * 2; float o0 = 0.f, o1 = 0.f;
      for (int i = 0; i < nsel; ++i) { const unsigned w = *(const unsigned*)(CN + (size_t)(b * SEQ + sel[i]) * 128 + r0); const float p = lg[h][i];
          o0 += p * __uint_as_float(w << 16); o1 += p * __uint_as_float(w & 0xffff0000u); }
      OLAT[(size_t)t * 512 + h * 128 + r0] = o0; OLAT[(size_t)t * 512 + h * 128 + r0 + 1] = o1; }
}

__global__ void __launch_bounds__(512) k_mix_naive(Args a) {
    const float* OLAT = (const float*)(a.ws + WS_OLAT); const float* OB = (const float*)(a.ws + WS_OB); const float* w_uv = a.in[3]; const float* hg = a.in[7];
    const bf16* AG = (const bf16*)(a.ws + WS_H16) + 2 * H16_STRIDE; const bf16* BG = (const bf16*)(a.ws + WS_H16) + 6 * H16_STRIDE; bf16* MIX = (bf16*)(a.ws + WS_MIX);
    __shared__ float ol[512]; __shared__ float ssq[8];
    const int tid = threadIdx.x, h = tid >> 7, v = tid & 127;
    for (int t = blockIdx.x; t < T_TOK; t += gridDim.x) {
        __syncthreads();
        ol[tid] = OLAT[(size_t)t * 512 + tid];
        const float ob = OB[(size_t)t * 512 + tid];
        const float ws = wave_sum(ob * ob);
        if ((tid & 63) == 0) ssq[tid >> 6] = ws;
        __syncthreads();
        float acc = 0.f;
        for (int r = 0; r < 128; ++r) acc += ol[h * 128 + r] * w_uv[(h * 128 + r) * 128 + v];
        const float oa = acc * bf2f(AG[(size_t)t * 512 + tid]);
        const float ms = (ssq[2 * h] + ssq[2 * h + 1]) * (1.0f / 128.0f);
        const float obn = ob * (1.0f / sqrtf(ms + 1e-6f)) * hg[tid] * bf2f(BG[(size_t)t * 512 + tid]);
        const unsigned short oah = (unsigned short)(pg8::pkbf(oa, 0.f) & 0xffffu), obh = (unsigned short)(pg8::pkbf(obn, 0.f) & 0xffffu);
        MIX[(size_t)t * 1024 + tid] = oah; MIX[(size_t)t * 1024 + 512 + tid] = obh;
    }
}

__global__ void __launch_bounds__(256) k_ln(Args a) {
    float* out = a.out; const float* g = a.in[9]; const float* bb = a.in[10];
    const int lane = threadIdx.x & 63, gw = (blockIdx.x * blockDim.x + threadIdx.x) >> 6, ngw = (gridDim.x * blockDim.x) >> 6;
    for (int t = gw; t < T_TOK; t += ngw) {
        f32x4* row = (f32x4*)(out + (size_t)t * 1024) + lane; f32x4 v[4]; float s = 0.f;
#pragma unroll
        for (int j = 0; j < 4; ++j) { v[j] = row[64 * j]; s += (v[j][0] + v[j][1]) + (v[j][2] + v[j][3]); }
        const float mean = wave_sum(s) * (1.0f / 1024.0f); float s2 = 0.f;
#pragma unroll
        for (int j = 0; j < 4; ++j) { v[j] = v[j] - mean; s2 += (v[j][0] * v[j][0] + v[j][1] * v[j][1]) + (v[j][2] * v[j][2] + v[j][3] * v[j][3]); }
        const float rstd = 1.0f / sqrtf(wave_sum(s2) * (1.0f / 1024.0f) + 1e-5f);
#pragma unroll
        for (int j = 0; j < 4; ++j) { const f32x4 gv = ((const f32x4*)g)[lane + 64 * j], bv = ((const f32x4*)bb)[lane + 64 * j]; row[64 * j] = v[j] * rstd * gv + bv; }
    }
}

extern "C" void kernel_launch(void* const* d_in, const int* in_sizes, int n_in, void* d_out, int out_size, void* d_ws, size_t ws_size, hipStream_t stream) {
    static int inited = 0;
    constexpr int GEMM_LDS = 131072;
    if (!inited) {
        if (n_in != 11 || out_size != T_TOK * DM || ws_size < WS_END) { fprintf(stderr, "kernel_launch: unexpected shapes (n_in %d, out %d, ws %zu)\n", n_in, out_size, ws_size); inited = -1; return; }
        if (hipFuncSetAttribute((const void*)k_gemm_in, hipFuncAttributeMaxDynamicSharedMemorySize, GEMM_LDS) != hipSuccess || hipFuncSetAttribute((const void*)k_gemm_out, hipFuncAttributeMaxDynamicSharedMemorySize, GEMM_LDS) != hipSuccess) { fprintf(stderr, "kernel_launch: hipFuncSetAttribute failed\n"); inited = -1; return; }
        inited = 1;
    }
    if (inited < 0) return;
    Args a{};
    for (int i = 0; i < 11; ++i) a.in[i] = (const float*)d_in[i];
    a.out = (float*)d_out; a.ws = (unsigned char*)d_ws;
    hipLaunchKernelGGL(k_prep, dim3(2048), dim3(256), 0, stream, a);
    hipLaunchKernelGGL(k_gemm_in, dim3(256), dim3(512), GEMM_LDS, stream, a);
    hipLaunchKernelGGL(k_post, dim3(1024), dim3(256), 0, stream, a);
    hipLaunchKernelGGL(k_hgrn_naive, dim3(64), dim3(128), 0, stream, a);
    hipLaunchKernelGGL(k_dsa_naive, dim3(T_TOK), dim3(256), 0, stream, a);
    hipLaunchKernelGGL(k_mix_naive, dim3(2048), dim3(512), 0, stream, a);
    hipLaunchKernelGGL(k_gemm_out, dim3(256), dim3(512), GEMM_LDS, stream, a);
    hipLaunchKernelGGL(k_ln, dim3(1024), dim3(256), 0, stream, a);
}
```

```cpp
#include <hip/hip_runtime.h>
#include <hip/hip_cooperative_groups.h>
#include <cstdio>
#include <cstdint>

constexpr int T_TOK = 32768, DM = 1024, SEQ = 2048, NBATCH = 16, NPROJ = 3840  , DIN = 3784;
constexpr float QSCALE = 0.08838834764831845f * 1.4426950408889634f;
constexpr float LOG2E = 1.4426950408889634f;
constexpr float IW_SCALE = 0.35355339059327373f * 0.125f;
constexpr float DN_ALPHA = 1.189207115002721f;
namespace pg8 {
#define PG8_LAS __attribute__((address_space(3)))
typedef unsigned short bf16_t;
typedef short bf16x8 __attribute__((ext_vector_type(8)));
typedef float f32x4 __attribute__((ext_vector_type(4)));
typedef unsigned u32x4 __attribute__((ext_vector_type(4)));
constexpr int BM = 256, BK = 64, HALF = 128, HTB = HALF * BK * 2  , STAGE_BYTES = 8 * HTB, NXCD = 8, WGM = 8;

__host__ __device__ __forceinline__ int lds_byte(int r, int c) { const int st = (r >> 4) * 2 + (c >> 5), rr = r & 15, cc = c & 31, ob = rr * 64 + cc * 2; return st * 1024 + (ob ^ (((ob >> 9) & 1) << 5)); }
__host__ __device__ __forceinline__ void stage_rc(int b, int& R, int& C) { const int st = b / 1024, sb = b % 1024, swz = sb ^ (((sb >> 9) & 1) << 5); R = (st >> 1) * 16 + swz / 64; C = (st & 1) * 32 + (swz % 64) / 2; }
__host__ __device__ __forceinline__ int perm32(int rho) { const int n = rho >> 4, i = rho & 15; return 8 * (i >> 2) + 4 * n + (i & 3); }

struct Unit { int pm, pn; };
struct Gemm { const bf16_t* A; const bf16_t* Bt; int M, N, K; };

struct StaticOrder {
    int nM, nN, nwg, G, c;
    __host__ __device__ void init(int M, int N, int G_, int c_) { nM = M / BM; nN = N / BM; nwg = nM * nN; G = G_; c = c_; }
    __host__ __device__ bool next(int i, Unit& u) const {
        const long L = (long)i * G + c; if (L >= nwg) return false;
        int wgid = (int)L; { const int q = nwg / NXCD, r = nwg % NXCD, xcd = wgid % NXCD, off = wgid / NXCD; wgid = (xcd < r ? xcd * (q + 1) : r * (q + 1) + (xcd - r) * q) + off; }
        const int nig = WGM * nN, gid = wgid / nig, fm = gid * WGM, gsz = (nM - fm) < WGM ? (nM - fm) : WGM;
        u.pm = fm + ((wgid % nig) % gsz); u.pn = (wgid % nig) / gsz; return true;
    }
    __device__ __forceinline__ void a_ready(const Unit&) const {}
    __device__ __forceinline__ void done(const Unit&) const {}
};

typedef float f32x2_t __attribute__((ext_vector_type(2)));
typedef __bf16 bf16x2_t __attribute__((ext_vector_type(2)));
typedef _Float16 f16x2_t __attribute__((ext_vector_type(2)));
__device__ __forceinline__ unsigned pkbf(float lo, float hi) { f32x2_t v = {lo, hi}; bf16x2_t b = __builtin_convertvector(v, bf16x2_t); return __builtin_bit_cast(unsigned, b); }
__device__ __forceinline__ unsigned pkh(float lo, float hi) { f32x2_t v = {lo, hi}; f16x2_t b = __builtin_convertvector(v, f16x2_t); return __builtin_bit_cast(unsigned, b); }
__device__ __forceinline__ float sigm(float x) { return __builtin_amdgcn_rcpf(1.0f + __builtin_amdgcn_exp2f(-1.4426950408889634f * x)); }
__device__ __forceinline__ float silu(float x) { return x * sigm(x); }

struct EpiInProj {
    static constexpr bool PERM = true, AFTER_DRAIN = false;
    unsigned short* base16; float* misc; const float* lb; size_t arr_stride;
    template <int ACT> __device__ __forceinline__ void store16(const f32x4 (&acc)[2][2][4][2], unsigned short* dst, int row0, const f32x4 (&lbv)[2][2]) const {
#pragma unroll
        for (int ai = 0; ai < 2; ++ai)
#pragma unroll
            for (int m = 0; m < 4; ++m) { unsigned short* rowp = dst + (size_t)(row0 + ai * HALF + m * 16) * 512;
#pragma unroll
                for (int bj = 0; bj < 2; ++bj) { f32x4 v0 = acc[ai][bj][m][0], v1 = acc[ai][bj][m][1]; u32x4 w;
                    if (ACT == 1) {
#pragma unroll
                        for (int e = 0; e < 4; ++e) { v0[e] = silu(v0[e]); v1[e] = silu(v1[e]); } }
                    if (ACT == 2) {
#pragma unroll
                        for (int e = 0; e < 4; ++e) { const float l0 = lbv[bj][0][e], l1 = lbv[bj][1][e];
                            v0[e] = 0.6931471805599453f * __builtin_amdgcn_logf(l0 + (1.0f - l0) * sigm(v0[e]));
                            v1[e] = 0.6931471805599453f * __builtin_amdgcn_logf(l1 + (1.0f - l1) * sigm(v1[e])); }
                        w.x = pkh(v0[0], v0[1]); w.y = pkh(v0[2], v0[3]); w.z = pkh(v1[0], v1[1]); w.w = pkh(v1[2], v1[3]);
                    } else { w.x = pkbf(v0[0], v0[1]); w.y = pkbf(v0[2], v0[3]); w.z = pkbf(v1[0], v1[1]); w.w = pkbf(v1[2], v1[3]); }
                    *(u32x4*)(rowp + bj * HALF) = w; } }
    }
    __device__ __forceinline__ void operator()(const f32x4 (&acc)[2][2][4][2], const Unit& u, int wr, int wc, int fr, int fq) const {
        const int row0 = u.pm * BM + wr * 64 + fr, cb = wc * 32 + 8 * fq;
        if (u.pn == 14) {
#pragma unroll
            for (int ai = 0; ai < 2; ++ai)
#pragma unroll
                for (int m = 0; m < 4; ++m) { float* rowp = misc + (size_t)(row0 + ai * HALF + m * 16) * 256 + cb;
#pragma unroll
                    for (int bj = 0; bj < 2; ++bj) { *(f32x4*)(rowp + bj * HALF) = acc[ai][bj][m][0]; *(f32x4*)(rowp + bj * HALF + 4) = acc[ai][bj][m][1]; } }
            return;
        }
        const int type = u.pn >> 1, ch = (u.pn & 1) * 256 + cb;
        unsigned short* dst = base16 + (size_t)type * arr_stride + ch;
        f32x4 lbv[2][2];
#pragma unroll
        for (int bj = 0; bj < 2; ++bj)
#pragma unroll
            for (int n = 0; n < 2; ++n) lbv[bj][n] = (type == 4) ? *(const f32x4*)(lb + ch + bj * HALF + 4 * n) : (f32x4){0.f, 0.f, 0.f, 0.f};
        if (type == 4) store16<2>(acc, dst, row0, lbv);
        else if (type == 2 || type == 3 || type == 6) store16<1>(acc, dst, row0, lbv);
        else store16<0>(acc, dst, row0, lbv);
    }
};
struct EpiOutRes {
    static constexpr bool PERM = false, AFTER_DRAIN = false;
    const float* x; float* out; float alpha;
    __device__ __forceinline__ void operator()(const f32x4 (&acc)[2][2][4][2], const Unit& u, int wr, int wc, int fr, int fq) const {
        const int row0 = u.pm * BM + wr * 64 + fr, col0 = u.pn * BM + wc * 32 + 4 * fq;
#pragma unroll
        for (int ai = 0; ai < 2; ++ai)
#pragma unroll
            for (int m = 0; m < 4; ++m) { const size_t off = (size_t)(row0 + ai * HALF + m * 16) * 1024 + col0;
#pragma unroll
                for (int bj = 0; bj < 2; ++bj)
#pragma unroll
                    for (int n = 0; n < 2; ++n) { const f32x4 xv = *(const f32x4*)(x + off + bj * HALF + n * 16); *(f32x4*)(out + off + bj * HALF + n * 16) = xv * alpha + acc[ai][bj][m][n]; } }
    }
};

template <class Epi, class Sched, bool ALIGN_EPI = false, bool SP2 = false>
__device__ __forceinline__ void gemm_phase(PG8_LAS unsigned char* lds, const Gemm g, const Sched& S, const Epi& E) {
    const int tid = threadIdx.x, wid = __builtin_amdgcn_readfirstlane(tid >> 6), lane = tid & 63, wr = wid >> 2, wc = wid & 3, fr = lane & 15, fq = lane >> 4;
    const int K = g.K, nt = K / BK;
    unsigned voffA[2], voffB[2];
#pragma unroll
    for (int i = 0; i < 2; ++i) { int R, C; stage_rc(tid * 16 + i * 8192, R, C); const int Rb = Epi::PERM ? ((R & ~31) + perm32(R & 31)) : R;
        voffA[i] = (unsigned)(R * K + C) * 2u; voffB[i] = (unsigned)(Rb * K + C) * 2u; }
    const size_t kstep = (size_t)(BK * 2);
    const size_t hstep = (size_t)HALF * K * 2;
    const size_t tstep = 2 * hstep;
    const unsigned ldsw = (unsigned)wid * 1024u;
    const int aoff = lds_byte(wr * 64 + fr, fq * 8), boff = lds_byte(wc * 32 + fr, fq * 8);
#define PG8_SA(b, h) (((b) * 2 + (h)) * HTB)
#define PG8_SB(b, h) ((4 + (b) * 2 + (h)) * HTB)
#define PG8_STAGE(bufoff, gbase, voff) do { _Pragma("unroll") for (int _i = 0; _i < 2; ++_i) \
        __builtin_amdgcn_global_load_lds((const unsigned*)((const char*)(gbase) + (voff)[_i]), (PG8_LAS unsigned*)(lds + (bufoff) + ldsw + _i * 8192), 16, 0, 0); } while (0)
#define PG8_LDA(dst, b, h) do { _Pragma("unroll") for (int m = 0; m < 4; ++m) _Pragma("unroll") for (int k = 0; k < 2; ++k) dst[m][k] = *(const PG8_LAS bf16x8*)(lds + PG8_SA(b, h) + aoff + m * 2048 + k * 1024); } while (0)
#define PG8_LDB(dst, b, h) do { _Pragma("unroll") for (int n = 0; n < 2; ++n) _Pragma("unroll") for (int k = 0; k < 2; ++k) dst[n][k] = *(const PG8_LAS bf16x8*)(lds + PG8_SB(b, h) + boff + n * 2048 + k * 1024); } while (0)
#define PG8_MMA(ai, bj, At, Bt) do { __builtin_amdgcn_s_setprio(1); _Pragma("unroll") for (int m = 0; m < 4; ++m) _Pragma("unroll") for (int n = 0; n < 2; ++n) _Pragma("unroll") for (int k = 0; k < 2; ++k) \
        acc[ai][bj][m][n] = __builtin_amdgcn_mfma_f32_16x16x32_bf16(Bt[n][k], At[m][k], acc[ai][bj][m][n], 0, 0, 0); __builtin_amdgcn_s_setprio(0); } while (0)
#define PG8_WAIT_V(n) asm volatile("s_waitcnt vmcnt(" #n ")" ::: "memory")
#define PG8_WAIT_L(n) asm volatile("s_waitcnt lgkmcnt(" #n ")" ::: "memory")
#define PG8_BAR __builtin_amdgcn_s_barrier()
#define PG8_SCHED __builtin_amdgcn_sched_barrier(0)
    Unit cur, nxt; int ui = 0;
    if (!S.next(0, cur)) return;
    f32x4 acc[2][2][4][2];
#pragma unroll
    for (int a = 0; a < 2; ++a)
#pragma unroll
        for (int b = 0; b < 2; ++b)
#pragma unroll
            for (int m = 0; m < 4; ++m)
#pragma unroll
                for (int n = 0; n < 2; ++n) acc[a][b][m][n] = (f32x4){0.f, 0.f, 0.f, 0.f};
    bf16x8 At[4][2], B0[2][2], B1[2][2];
    const char* cA = (const char*)g.A + (size_t)cur.pm * tstep; const char* cB = (const char*)g.Bt + (size_t)cur.pn * tstep;
    S.a_ready(cur);
    if constexpr (SP2) {
        PG8_STAGE(PG8_SB(0, 0), cB, voffB); PG8_STAGE(PG8_SB(0, 1), cB + hstep, voffB); PG8_STAGE(PG8_SA(0, 0), cA, voffA); PG8_STAGE(PG8_SA(0, 1), cA + hstep, voffA);
        if (wr == 1) PG8_BAR;
        PG8_WAIT_V(2); PG8_BAR;
        PG8_STAGE(PG8_SB(1, 0), cB + kstep, voffB); PG8_STAGE(PG8_SA(1, 0), cA + kstep, voffA); PG8_STAGE(PG8_SB(1, 1), cB + hstep + kstep, voffB);
        PG8_WAIT_V(6); PG8_BAR;
    } else {
        PG8_STAGE(PG8_SB(0, 0), cB, voffB); PG8_STAGE(PG8_SA(0, 0), cA, voffA); PG8_STAGE(PG8_SB(0, 1), cB + hstep, voffB); PG8_STAGE(PG8_SA(0, 1), cA + hstep, voffA);
        if (wr == 1) PG8_BAR;
        PG8_WAIT_V(4); PG8_BAR;
        PG8_STAGE(PG8_SB(1, 0), cB + kstep, voffB); PG8_STAGE(PG8_SA(1, 0), cA + kstep, voffA); PG8_STAGE(PG8_SB(1, 1), cB + hstep + kstep, voffB);
        PG8_WAIT_V(6); PG8_BAR;
    }
    for (;;) {
        const bool has_next = S.next(ui + 1, nxt);
        const char* nA = has_next ? (const char*)g.A + (size_t)nxt.pm * tstep : cA; const char* nB = has_next ? (const char*)g.Bt + (size_t)nxt.pn * tstep : cB;
        for (int t = 0; t < nt; t += 2) {
            const bool last = (t == nt - 2);
            const char* a1 = cA + (size_t)(t + 1) * kstep;
            const char* a2 = last ? nA : cA + (size_t)(t + 2) * kstep; const char* b2 = last ? nB : cB + (size_t)(t + 2) * kstep;
            const char* a3 = a2 + kstep; const char* b3 = b2 + kstep;
            if (last && has_next) S.a_ready(nxt);
            if constexpr (SP2) {
            PG8_LDB(B0, 0, 0); PG8_LDB(B1, 0, 1); PG8_SCHED; PG8_LDA(At, 0, 0); PG8_STAGE(PG8_SA(1, 1), a1 + hstep, voffA);
            PG8_WAIT_V(8); PG8_WAIT_L(0); PG8_BAR; PG8_MMA(0, 0, At, B0); PG8_MMA(0, 1, At, B1); PG8_BAR; PG8_SCHED;
            PG8_LDA(At, 0, 1); PG8_STAGE(PG8_SB(0, 0), b2, voffB); PG8_STAGE(PG8_SB(0, 1), b2 + hstep, voffB); PG8_STAGE(PG8_SA(0, 0), a2, voffA);
            PG8_WAIT_V(8); PG8_WAIT_L(0); PG8_BAR; PG8_MMA(1, 0, At, B0); PG8_MMA(1, 1, At, B1); PG8_BAR; PG8_SCHED;
            PG8_LDB(B0, 1, 0); PG8_LDB(B1, 1, 1); PG8_SCHED; PG8_LDA(At, 1, 0); PG8_STAGE(PG8_SA(0, 1), a2 + hstep, voffA);
            PG8_WAIT_V(8); PG8_WAIT_L(0); PG8_BAR; PG8_MMA(0, 0, At, B0); PG8_MMA(0, 1, At, B1); PG8_BAR; PG8_SCHED;
            PG8_LDA(At, 1, 1); PG8_STAGE(PG8_SB(1, 0), b3, voffB); PG8_STAGE(PG8_SB(1, 1), b3 + hstep, voffB); PG8_STAGE(PG8_SA(1, 0), a3, voffA);
            PG8_WAIT_V(8); PG8_WAIT_L(0); PG8_BAR; PG8_MMA(1, 0, At, B0); PG8_MMA(1, 1, At, B1); PG8_BAR; PG8_SCHED;
            } else {
            PG8_LDB(B0, 0, 0); PG8_SCHED; PG8_LDA(At, 0, 0); PG8_STAGE(PG8_SA(1, 1), a1 + hstep, voffA);
            PG8_WAIT_L(8); PG8_BAR; PG8_WAIT_L(0); PG8_MMA(0, 0, At, B0); PG8_BAR; PG8_SCHED;
            PG8_LDB(B1, 0, 1); PG8_STAGE(PG8_SB(0, 0), b2, voffB);
            PG8_BAR; PG8_WAIT_L(0); PG8_MMA(0, 1, At, B1); PG8_BAR;
            PG8_LDA(At, 0, 1); PG8_STAGE(PG8_SA(0, 0), a2, voffA);
            PG8_BAR; PG8_WAIT_L(0); PG8_MMA(1, 0, At, B0); PG8_BAR; PG8_SCHED;
            PG8_STAGE(PG8_SB(0, 1), b2 + hstep, voffB);
            PG8_WAIT_V(6); PG8_BAR; PG8_MMA(1, 1, At, B1); PG8_BAR;
            PG8_LDB(B0, 1, 0); PG8_SCHED; PG8_LDA(At, 1, 0); PG8_STAGE(PG8_SA(0, 1), a2 + hstep, voffA);
            PG8_WAIT_L(8); PG8_BAR; PG8_WAIT_L(0); PG8_MMA(0, 0, At, B0); PG8_BAR; PG8_SCHED;
            PG8_LDB(B1, 1, 1); PG8_STAGE(PG8_SB(1, 0), b3, voffB);
            PG8_BAR; PG8_WAIT_L(0); PG8_MMA(0, 1, At, B1); PG8_BAR;
            PG8_LDA(At, 1, 1); PG8_STAGE(PG8_SA(1, 0), a3, voffA);
            PG8_BAR; PG8_WAIT_L(0); PG8_MMA(1, 0, At, B0); PG8_BAR; PG8_SCHED;
            PG8_STAGE(PG8_SB(1, 1), b3 + hstep, voffB);
            PG8_WAIT_V(6); PG8_BAR; PG8_MMA(1, 1, At, B1); PG8_BAR;
            }
        }
        if constexpr (ALIGN_EPI) { if (wr == 0) PG8_BAR; }
        if constexpr (!Epi::AFTER_DRAIN) { E(acc, cur, wr, wc, fr, fq); S.done(cur); }
        if (!has_next) break;
#pragma unroll
        for (int a = 0; a < 2; ++a)
#pragma unroll
            for (int b = 0; b < 2; ++b)
#pragma unroll
                for (int m = 0; m < 4; ++m)
#pragma unroll
                    for (int n = 0; n < 2; ++n) acc[a][b][m][n] = (f32x4){0.f, 0.f, 0.f, 0.f};
        cur = nxt; cA = nA; cB = nB; ++ui;
        if constexpr (ALIGN_EPI) { if (wr == 1) PG8_BAR; }
    }
    PG8_WAIT_V(0);
    if constexpr (!ALIGN_EPI) { if (wr == 0) PG8_BAR; }
    PG8_BAR;
    if constexpr (Epi::AFTER_DRAIN) { E.fused(acc, cur, wr, wc, fr, fq, lds, wid, lane); S.done(cur); }
#undef PG8_SA
#undef PG8_SB
#undef PG8_STAGE
#undef PG8_LDA
#undef PG8_LDB
#undef PG8_MMA
#undef PG8_WAIT_V
#undef PG8_WAIT_L
#undef PG8_BAR
#undef PG8_SCHED
}
}

constexpr size_t MiB = 1u << 20;
constexpr size_t WS_CTL = 0;
constexpr size_t WS_WTIN = 2 * MiB;
constexpr size_t WS_WTO = 10 * MiB;
constexpr size_t WS_LB = 12 * MiB;
constexpr size_t WS_XB = 16 * MiB;
constexpr size_t WS_MIX = 16 * MiB;
constexpr size_t WS_H16 = 80 * MiB;
constexpr size_t H16_STRIDE = (size_t)T_TOK * 512;
constexpr size_t WS_MISC = 304 * MiB;
constexpr size_t WS_CN = 336 * MiB;
constexpr size_t WS_IKB = 344 * MiB;
constexpr size_t WS_IWF = 348 * MiB;
constexpr size_t WS_OB = 352 * MiB;
constexpr size_t WS_OLAT = 416 * MiB;
constexpr size_t WS_END = 480 * MiB;

typedef unsigned short bf16;
typedef unsigned v4u __attribute__((ext_vector_type(4)));
typedef float f32x4 __attribute__((ext_vector_type(4)));
__device__ __forceinline__ float bf2f(unsigned short b) { return __uint_as_float((unsigned)b << 16); }
__device__ __forceinline__ float h2f(unsigned short b) { return (float)__builtin_bit_cast(_Float16, b); }
__device__ __forceinline__ float wave_sum(float v) {
#pragma unroll
    for (int o = 1; o < 64; o <<= 1) v += __shfl_xor(v, o);
    return v;
}
__device__ __forceinline__ float wave_max(float v) {
#pragma unroll
    for (int o = 1; o < 64; o <<= 1) v = fmaxf(v, __shfl_xor(v, o));
    return v;
}

struct Args { const float* in[11]; float* out; unsigned char* ws; };

__device__ __forceinline__ int src_col(int n) {
    if (n < 1024) return 640 + (n - 512);
    if (n < 1536) return 1224 + (n - 1024);
    if (n < 2048) return 1736 + (n - 1536);
    if (n < 2560) return 2248 + (n - 2048);
    if (n < 3072) return 2760 + (n - 2560);
    if (n < 3584) return 3272 + (n - 3072);
    if (n < 3712) return 512 + (n - 3584);
    if (n < 3776) return 1152 + (n - 3712);
    return 1216 + (n - 3776);
}

__device__ __forceinline__ void p0_prep(const Args& a, long gtid, long gsize) {
    const float* x = a.in[0]; const float* w_in = a.in[1]; const float* w_uk = a.in[2]; const float* lbl = a.in[6]; const float* w_o = a.in[8];
    bf16* XB = (bf16*)(a.ws + WS_XB); bf16* WTIN = (bf16*)(a.ws + WS_WTIN); bf16* WTO = (bf16*)(a.ws + WS_WTO); float* LB = (float*)(a.ws + WS_LB);
    constexpr long I_W = (long)NPROJ * 128, I_O = 1024L * 128, I_LB = 512, I_X = (long)T_TOK * DM / 8;
    for (long i = gtid; i < I_W + I_O + I_LB + I_X; i += gsize) {
        if (i < I_W) {
            const int n = (int)(i % NPROJ), k0 = (int)(i / NPROJ) * 8; float v[8];
            if (n < 512) {
                const int h = n >> 7, r = n & 127;
#pragma unroll
                for (int j = 0; j < 8; ++j) v[j] = 0.f;
                for (int d = 0; d < 128; ++d) { const float wu = w_uk[(h * 128 + d) * 128 + r];
#pragma unroll
                    for (int j = 0; j < 8; ++j) v[j] += w_in[(size_t)(k0 + j) * DIN + h * 128 + d] * wu; }
#pragma unroll
                for (int j = 0; j < 8; ++j) v[j] *= QSCALE;
            } else if (n < DIN) { const int sc = src_col(n);
#pragma unroll
                for (int j = 0; j < 8; ++j) v[j] = w_in[(size_t)(k0 + j) * DIN + sc];
            } else {
#pragma unroll
                for (int j = 0; j < 8; ++j) v[j] = 0.f;
            }
            v4u o; o.x = pg8::pkbf(v[0], v[1]); o.y = pg8::pkbf(v[2], v[3]); o.z = pg8::pkbf(v[4], v[5]); o.w = pg8::pkbf(v[6], v[7]);
            *(v4u*)(WTIN + (size_t)n * DM + k0) = o;
        } else if (i < I_W + I_O) {
            const long ii = i - I_W; const int n = (int)(ii % 1024), k0 = (int)(ii / 1024) * 8; float v[8];
#pragma unroll
            for (int j = 0; j < 8; ++j) v[j] = w_o[(size_t)(k0 + j) * 1024 + n];
            v4u o; o.x = pg8::pkbf(v[0], v[1]); o.y = pg8::pkbf(v[2], v[3]); o.z = pg8::pkbf(v[4], v[5]); o.w = pg8::pkbf(v[6], v[7]);
            *(v4u*)(WTO + (size_t)n * 1024 + k0) = o;
        } else if (i < I_W + I_O + I_LB) {
            const int c = (int)(i - I_W - I_O);
            LB[c] = 1.0f / (1.0f + expf(lbl[512 + c] - lbl[c]));
        } else {
            const long ii = i - I_W - I_O - I_LB;
            const f32x4 p = ((const f32x4*)x)[2 * ii], q = ((const f32x4*)x)[2 * ii + 1];
            v4u o; o.x = pg8::pkbf(p[0], p[1]); o.y = pg8::pkbf(p[2], p[3]); o.z = pg8::pkbf(q[0], q[1]); o.w = pg8::pkbf(q[2], q[3]);
            ((v4u*)XB)[ii] = o;
        }
    }
}

namespace cg = cooperative_groups;
constexpr int NTHR = 512;
constexpr int LDS_BYTES = 147456;

__device__ __forceinline__ void ph_gemm_in(const Args& a, unsigned char* lds) {
    pg8::Gemm g{(const pg8::bf16_t*)(a.ws + WS_XB), (const pg8::bf16_t*)(a.ws + WS_WTIN), T_TOK, NPROJ, DM};
    pg8::StaticOrder S; S.init(T_TOK, NPROJ, (int)gridDim.x, (int)blockIdx.x);
    pg8::EpiInProj E{(unsigned short*)(a.ws + WS_H16), (float*)(a.ws + WS_MISC), (const float*)(a.ws + WS_LB), H16_STRIDE};
    pg8::gemm_phase<pg8::EpiInProj, pg8::StaticOrder, true, true>((PG8_LAS unsigned char*)lds, g, S, E);
}
__device__ __forceinline__ void ph_gemm_out(const Args& a, unsigned char* lds) {
    pg8::Gemm g{(const pg8::bf16_t*)(a.ws + WS_MIX), (const pg8::bf16_t*)(a.ws + WS_WTO), T_TOK, DM, DM};
    pg8::StaticOrder S; S.init(T_TOK, DM, (int)gridDim.x, (int)blockIdx.x);
    pg8::EpiOutRes E{a.in[0], a.out, DN_ALPHA};
    pg8::gemm_phase<pg8::EpiOutRes, pg8::StaticOrder, true, true>((PG8_LAS unsigned char*)lds, g, S, E);
}

__device__ __forceinline__ void ph_post(const Args& a) {
    const float* misc = (const float*)(a.ws + WS_MISC); const float* kvg = a.in[4];
    bf16* CN = (bf16*)(a.ws + WS_CN); bf16* IKB = (bf16*)(a.ws + WS_IKB); float* IWF = (float*)(a.ws + WS_IWF);
    const int lane = threadIdx.x & 63, gw = (blockIdx.x * NTHR + threadIdx.x) >> 6, ngw = (gridDim.x * NTHR) >> 6;
    for (int t = gw; t < T_TOK; t += ngw) {
        const float* row = misc + (size_t)t * 256;
        const float c0 = row[2 * lane], c1 = row[2 * lane + 1];
        const float ms = wave_sum(c0 * c0 + c1 * c1) * (1.0f / 128.0f);
        const float rs = 1.0f / sqrtf(ms + 1e-6f);
        ((unsigned*)CN)[(size_t)t * 64 + lane] = pg8::pkbf(c0 * rs * kvg[2 * lane], c1 * rs * kvg[2 * lane + 1]);
        const float k0 = row[128 + lane]; const float k1 = __shfl_xor(k0, 1);
        if ((lane & 1) == 0) ((unsigned*)IKB)[(size_t)t * 32 + (lane >> 1)] = pg8::pkbf(k0, k1);
        if (lane < 8) IWF[(size_t)t * 8 + lane] = row[192 + lane] * IW_SCALE;
    }
}

__device__ __forceinline__ void ph_hgrn_naive(const Args& a, unsigned char* lds) {
    const bf16* BQ = (const bf16*)(a.ws + WS_H16) + 3 * H16_STRIDE; const bf16* BF = (const bf16*)(a.ws + WS_H16) + 4 * H16_STRIDE; const bf16* BI = (const bf16*)(a.ws + WS_H16) + 5 * H16_STRIDE;
    float* OB = (float*)(a.ws + WS_OB);
    if (blockIdx.x >= 16) return;
    const int grp = threadIdx.x >> 7, v = threadIdx.x & 127, item = blockIdx.x * 4 + grp, b = item >> 2, h = item & 3;
    float* qs = (float*)lds + grp * 2048; float* fs = qs + 1024;
    float st[128];
#pragma unroll
    for (int k = 0; k < 128; ++k) st[k] = 0.f;
    for (int t0 = 0; t0 < SEQ; t0 += 8) {
        __syncthreads();
#pragma unroll
        for (int tt = 0; tt < 8; ++tt) { const size_t off = (size_t)(b * SEQ + t0 + tt) * 512 + h * 128 + v; qs[tt * 128 + v] = bf2f(BQ[off]); fs[tt * 128 + v] = __expf(h2f(BF[off])); }
        __syncthreads();
#pragma unroll 1
        for (int tt = 0; tt < 8; ++tt) {
            const size_t off = (size_t)(b * SEQ + t0 + tt) * 512 + h * 128 + v;
            const float vv = bf2f(BI[off]); float o = 0.f;
#pragma unroll
            for (int k = 0; k < 128; ++k) { const float f = fs[tt * 128 + k]; st[k] = f * st[k] + (1.0f - f) * vv; o += qs[tt * 128 + k] * st[k]; }
            OB[off] = o;
        }
    }
    __syncthreads();
}

__device__ __forceinline__ int t5_bucket(int rel) {
    const int n = rel < 0 ? -rel : rel; int bk;
    if (n < 8) bk = n; else bk = 8 + (n >= 13) + (n >= 20) + (n >= 30) + (n >= 46) + (n >= 70) + (n >= 108) + (n >= 166);
    return bk + (rel > 0 ? 16 : 0);
}
__device__ __forceinline__ int fkey(float f) { const int b = __float_as_int(f); return b ^ ((b >> 31) & 0x7fffffff); }
__device__ __forceinline__ void ph_dsa_naive(const Args& a, unsigned char* lds) {
    const bf16* QL = (const bf16*)(a.ws + WS_H16); const bf16* IQ = (const bf16*)(a.ws + WS_H16) + 1 * H16_STRIDE;
    const bf16* CN = (const bf16*)(a.ws + WS_CN); const bf16* IKB = (const bf16*)(a.ws + WS_IKB); const float* IWF = (const float*)(a.ws + WS_IWF);
    const float* rel_bias = a.in[5]; float* OLAT = (float*)(a.ws + WS_OLAT);
    float* sc = (float*)lds; float* iqs = sc + 2048; float* qls = iqs + 512; float* wsh = qls + 512; int* sel = (int*)(wsh + 8); float* lg = (float*)(sel + 256); int* cnt_p = (int*)(lg + 1024); int* scan_s = cnt_p + 8;
    const int tid = threadIdx.x;
    for (int t = blockIdx.x; t < T_TOK; t += gridDim.x) {
        const int b = t >> 11, s = t & 2047, c = s >> 6, nk = 64 * (c + 1);
        __syncthreads();
        iqs[tid] = bf2f(IQ[(size_t)t * 512 + tid]); qls[tid] = bf2f(QL[(size_t)t * 512 + tid]);
        if (tid < 8) wsh[tid] = IWF[(size_t)t * 8 + tid];
        __syncthreads();
        int nsel;
        if (nk <= 256) {
            if (tid < nk) sel[tid] = tid;
            nsel = nk;
        } else {
            for (int key = tid; key < nk; key += NTHR) {
                const v4u* kp = (const v4u*)(IKB + (size_t)(b * SEQ + key) * 64); float kv[64];
#pragma unroll
                for (int q = 0; q < 8; ++q) { const v4u w = kp[q];
                    kv[8 * q + 0] = __uint_as_float(w.x << 16); kv[8 * q + 1] = __uint_as_float(w.x & 0xffff0000u); kv[8 * q + 2] = __uint_as_float(w.y << 16); kv[8 * q + 3] = __uint_as_float(w.y & 0xffff0000u);
                    kv[8 * q + 4] = __uint_as_float(w.z << 16); kv[8 * q + 5] = __uint_as_float(w.z & 0xffff0000u); kv[8 * q + 6] = __uint_as_float(w.w << 16); kv[8 * q + 7] = __uint_as_float(w.w & 0xffff0000u); }
                float score = 0.f;
#pragma unroll 1
                for (int h = 0; h < 8; ++h) { float d = 0.f;
#pragma unroll
                    for (int e = 0; e < 64; ++e) d += iqs[h * 64 + e] * kv[e];
                    score += wsh[h] * fmaxf(d, 0.f); }
                sc[key] = score + 0.0f;
            }
            __syncthreads();
            int u[4];
#pragma unroll
            for (int j = 0; j < 4; ++j) { const int key = tid * 4 + j; u[j] = key < nk ? fkey(sc[key]) : (int)0x80000000; }
            long long lo = (long long)(int)0x80000000, hi = 0x7fffffffLL; int thr = 0; bool exact = false; int cnt_hi = 0;
            for (;;) {
                if (hi - lo <= 1) break;
                const int mid = (int)(lo + (hi - lo) / 2);
                if (tid == 0) *cnt_p = 0;
                __syncthreads();
                int lc = 0;
#pragma unroll
                for (int j = 0; j < 4; ++j) lc += (u[j] > mid) ? 1 : 0;
                if (lc) atomicAdd(cnt_p, lc);
                __syncthreads();
                const int cnt = *cnt_p;
                __syncthreads();
                if (cnt == 256) { thr = mid; exact = true; break; }
                if (cnt > 256) lo = mid; else { hi = mid; cnt_hi = cnt; }
            }
            int flag[4]; int lc = 0;
            if (exact) {
#pragma unroll
                for (int j = 0; j < 4; ++j) { flag[j] = (u[j] > thr) ? 1 : 0; lc += flag[j]; }
            } else {
                const int vk = (int)hi;
                int eq = 0;
#pragma unroll
                for (int j = 0; j < 4; ++j) eq += (u[j] == vk) ? 1 : 0;
                scan_s[tid] = eq; __syncthreads();
                int before = 0; for (int i = 0; i < tid; ++i) before += scan_s[i];
                __syncthreads();
                const int need = 256 - cnt_hi;
#pragma unroll
                for (int j = 0; j < 4; ++j) { int f = (u[j] > vk) ? 1 : 0; if (u[j] == vk) { if (before < need) f = 1; ++before; } flag[j] = f; lc += f; }
            }
            scan_s[tid] = lc; __syncthreads();
            int pos = 0; for (int i = 0; i < tid; ++i) pos += scan_s[i];
#pragma unroll
            for (int j = 0; j < 4; ++j) if (flag[j]) { if (pos < 256) sel[pos] = tid * 4 + j; ++pos; }
            nsel = 256;
        }
        __syncthreads();
        if (tid < nsel) {
            const int key = sel[tid]; const v4u* cp = (const v4u*)(CN + (size_t)(b * SEQ + key) * 128);
            float d0 = 0.f, d1 = 0.f, d2 = 0.f, d3 = 0.f;
#pragma unroll 2
            for (int q = 0; q < 16; ++q) { const v4u w = cp[q]; float cv[8];
                cv[0] = __uint_as_float(w.x << 16); cv[1] = __uint_as_float(w.x & 0xffff0000u); cv[2] = __uint_as_float(w.y << 16); cv[3] = __uint_as_float(w.y & 0xffff0000u);
                cv[4] = __uint_as_float(w.z << 16); cv[5] = __uint_as_float(w.z & 0xffff0000u); cv[6] = __uint_as_float(w.w << 16); cv[7] = __uint_as_float(w.w & 0xffff0000u);
#pragma unroll
                for (int e = 0; e < 8; ++e) { d0 += qls[8 * q + e] * cv[e]; d1 += qls[128 + 8 * q + e] * cv[e]; d2 += qls[256 + 8 * q + e] * cv[e]; d3 += qls[384 + 8 * q + e] * cv[e]; } }
            const int bk = t5_bucket(key - s);
            lg[tid] = d0 + LOG2E * rel_bias[bk * 4 + 0]; lg[256 + tid] = d1 + LOG2E * rel_bias[bk * 4 + 1]; lg[512 + tid] = d2 + LOG2E * rel_bias[bk * 4 + 2]; lg[768 + tid] = d3 + LOG2E * rel_bias[bk * 4 + 3];
        }
        __syncthreads();
        if (tid < 256) { const int h = tid >> 6, lane = tid & 63; float v[4]; float m = -INFINITY;
#pragma unroll
          for (int j = 0; j < 4; ++j) { const int i = lane + 64 * j; v[j] = i < nsel ? lg[h * 256 + i] : -INFINITY; m = fmaxf(m, v[j]); }
          m = wave_max(m); float sum = 0.f;
#pragma unroll
          for (int j = 0; j < 4; ++j) { v[j] = exp2f(v[j] - m); sum += v[j]; }
          sum = wave_sum(sum); const float inv = 1.0f / sum;
#pragma unroll
          for (int j = 0; j < 4; ++j) { const int i = lane + 64 * j; if (i < nsel) lg[h * 256 + i] = v[j] * inv; } }
        __syncthreads();
        { const int h = tid >> 7, r = tid & 127; float o0 = 0.f;
          for (int i = 0; i < nsel; ++i) o0 += lg[h * 256 + i] * bf2f(CN[(size_t)(b * SEQ + sel[i]) * 128 + r]);
          OLAT[(size_t)t * 512 + tid] = o0; }
    }
    __syncthreads();
}

__device__ __forceinline__ void ph_mix_naive(const Args& a, unsigned char* lds) {
    const float* OLAT = (const float*)(a.ws + WS_OLAT); const float* OB = (const float*)(a.ws + WS_OB); const float* w_uv = a.in[3]; const float* hg = a.in[7];
    const bf16* AG = (const bf16*)(a.ws + WS_H16) + 2 * H16_STRIDE; const bf16* BG = (const bf16*)(a.ws + WS_H16) + 6 * H16_STRIDE; bf16* MIX = (bf16*)(a.ws + WS_MIX);
    float* ol = (float*)lds; float* ssq = ol + 512;
    const int tid = threadIdx.x, h = tid >> 7, v = tid & 127;
    for (int t = blockIdx.x; t < T_TOK; t += gridDim.x) {
        __syncthreads();
        ol[tid] = OLAT[(size_t)t * 512 + tid];
        const float ob = OB[(size_t)t * 512 + tid];
        const float ws = wave_sum(ob * ob);
        if ((tid & 63) == 0) ssq[tid >> 6] = ws;
        __syncthreads();
        float acc = 0.f;
        for (int r = 0; r < 128; ++r) acc += ol[h * 128 + r] * w_uv[(h * 128 + r) * 128 + v];
        const float oa = acc * bf2f(AG[(size_t)t * 512 + tid]);
        const float ms = (ssq[2 * h] + ssq[2 * h + 1]) * (1.0f / 128.0f);
        const float obn = ob * (1.0f / sqrtf(ms + 1e-6f)) * hg[tid] * bf2f(BG[(size_t)t * 512 + tid]);
        MIX[(size_t)t * 1024 + tid] = (unsigned short)(pg8::pkbf(oa, 0.f) & 0xffffu); MIX[(size_t)t * 1024 + 512 + tid] = (unsigned short)(pg8::pkbf(obn, 0.f) & 0xffffu);
    }
    __syncthreads();
}

__device__ __forceinline__ void ph_ln(const Args& a) {
    float* out = a.out; const float* g = a.in[9]; const float* bb = a.in[10];
    const int lane = threadIdx.x & 63, gw = (blockIdx.x * NTHR + threadIdx.x) >> 6, ngw = (gridDim.x * NTHR) >> 6;
    for (int t = gw; t < T_TOK; t += ngw) {
        f32x4* row = (f32x4*)(out + (size_t)t * 1024) + lane; f32x4 v[4]; float s = 0.f;
#pragma unroll
        for (int j = 0; j < 4; ++j) { v[j] = row[64 * j]; s += (v[j][0] + v[j][1]) + (v[j][2] + v[j][3]); }
        const float mean = wave_sum(s) * (1.0f / 1024.0f); float s2 = 0.f;
#pragma unroll
        for (int j = 0; j < 4; ++j) { v[j] = v[j] - mean; s2 += (v[j][0] * v[j][0] + v[j][1] * v[j][1]) + (v[j][2] * v[j][2] + v[j][3] * v[j][3]); }
        const float rstd = 1.0f / sqrtf(wave_sum(s2) * (1.0f / 1024.0f) + 1e-5f);
#pragma unroll
        for (int j = 0; j < 4; ++j) { const f32x4 gv = ((const f32x4*)g)[lane + 64 * j], bv = ((const f32x4*)bb)[lane + 64 * j]; row[64 * j] = v[j] * rstd * gv + bv; }
    }
}

__global__ void __launch_bounds__(NTHR, 2) mk_fwd(Args a) {
    extern __shared__ __attribute__((aligned(16))) unsigned char lds[];
    cg::grid_group grid = cg::this_grid();
    p0_prep(a, (long)blockIdx.x * NTHR + threadIdx.x, (long)gridDim.x * NTHR);
    grid.sync();
    ph_gemm_in(a, lds);
    grid.sync();
    ph_post(a);
    ph_hgrn_naive(a, lds);
    grid.sync();
    ph_dsa_naive(a, lds);
    grid.sync();
    ph_mix_naive(a, lds);
    grid.sync();
    ph_gemm_out(a, lds);
    grid.sync();
    ph_ln(a);
}

extern "C" void kernel_launch(void* const* d_in, const int* in_sizes, int n_in, void* d_out, int out_size, void* d_ws, size_t ws_size, hipStream_t stream) {
    static int grid = 0;
    if (grid == 0) {
        if (n_in != 11 || out_size != T_TOK * DM || ws_size < WS_END) { fprintf(stderr, "kernel_launch: unexpected shapes (n_in %d, out %d, ws %zu)\n", n_in, out_size, ws_size); grid = -1; return; }
        if (hipFuncSetAttribute((const void*)mk_fwd, hipFuncAttributeMaxDynamicSharedMemorySize, LDS_BYTES) != hipSuccess) { fprintf(stderr, "kernel_launch: hipFuncSetAttribute failed\n"); grid = -1; return; }
        int dev = 0, cus = 0, per_cu = 0;
        (void)hipGetDevice(&dev); (void)hipDeviceGetAttribute(&cus, hipDeviceAttributeMultiprocessorCount, dev);
        (void)hipOccupancyMaxActiveBlocksPerMultiprocessor(&per_cu, (const void*)mk_fwd, NTHR, LDS_BYTES);
        if (per_cu < 1 || cus < 1) { fprintf(stderr, "kernel_launch: occupancy query says %d blocks/CU on %d CUs\n", per_cu, cus); grid = -1; return; }
        grid = cus;
        fprintf(stderr, "kernel_launch: %d CUs, %d blocks/CU by the occupancy query, grid %d\n", cus, per_cu, grid);
    }
    if (grid < 0) return;
    Args a{};
    for (int i = 0; i < 11; ++i) a.in[i] = (const float*)d_in[i];
    a.out = (float*)d_out; a.ws = (unsigned char*)d_ws;
    void* params[] = {&a};
    hipError_t e = hipLaunchCooperativeKernel((const void*)mk_fwd, dim3(grid), dim3(NTHR), params, LDS_BYTES, stream);
    if (e != hipSuccess) fprintf(stderr, "kernel_launch: cooperative launch failed: %s (grid %d)\n", hipGetErrorString(e), grid);
}
```

```cpp
#include <hip/hip_runtime.h>
#include <hip/hip_cooperative_groups.h>
#include <cstdio>
#include <cstdint>

constexpr int T_TOK = 32768, DM = 1024, SEQ = 2048, NBATCH = 16, NPROJ = 3840  , DIN = 3784;
constexpr float QSCALE = 0.08838834764831845f * 1.4426950408889634f;
constexpr float LOG2E = 1.4426950408889634f;
constexpr float IW_SCALE = 0.35355339059327373f * 0.125f;
constexpr float DN_ALPHA = 1.189207115002721f;
namespace pg8 {
#define PG8_LAS __attribute__((address_space(3)))
typedef unsigned short bf16_t;
typedef short bf16x8 __attribute__((ext_vector_type(8)));
typedef float f32x4 __attribute__((ext_vector_type(4)));
typedef unsigned u32x4 __attribute__((ext_vector_type(4)));
constexpr int BM = 256, BK = 64, HALF = 128, HTB = HALF * BK * 2  , STAGE_BYTES = 8 * HTB, NXCD = 8, WGM = 8;

__host__ __device__ __forceinline__ int lds_byte(int r, int c) { const int st = (r >> 4) * 2 + (c >> 5), rr = r & 15, cc = c & 31, ob = rr * 64 + cc * 2; return st * 1024 + (ob ^ (((ob >> 9) & 1) << 5)); }
__host__ __device__ __forceinline__ void stage_rc(int b, int& R, int& C) { const int st = b / 1024, sb = b % 1024, swz = sb ^ (((sb >> 9) & 1) << 5); R = (st >> 1) * 16 + swz / 64; C = (st & 1) * 32 + (swz % 64) / 2; }
__host__ __device__ __forceinline__ int perm32(int rho) { const int n = rho >> 4, i = rho & 15; return 8 * (i >> 2) + 4 * n + (i & 3); }

struct Unit { int pm, pn; };
struct Gemm { const bf16_t* A; const bf16_t* Bt; int M, N, K; };

struct StaticOrder {
    int nM, nN, nwg, G, c;
    __host__ __device__ void init(int M, int N, int G_, int c_) { nM = M / BM; nN = N / BM; nwg = nM * nN; G = G_; c = c_; }
    __host__ __device__ bool next(int i, Unit& u) const {
        const long L = (long)i * G + c; if (L >= nwg) return false;
        int wgid = (int)L; { const int q = nwg / NXCD, r = nwg % NXCD, xcd = wgid % NXCD, off = wgid / NXCD; wgid = (xcd < r ? xcd * (q + 1) : r * (q + 1) + (xcd - r) * q) + off; }
        const int nig = WGM * nN, gid = wgid / nig, fm = gid * WGM, gsz = (nM - fm) < WGM ? (nM - fm) : WGM;
        u.pm = fm + ((wgid % nig) % gsz); u.pn = (wgid % nig) / gsz; return true;
    }
    __device__ __forceinline__ void a_ready(const Unit&) const {}
    __device__ __forceinline__ void done(const Unit&) const {}
};

typedef float f32x2_t __attribute__((ext_vector_type(2)));
typedef __bf16 bf16x2_t __attribute__((ext_vector_type(2)));
typedef _Float16 f16x2_t __attribute__((ext_vector_type(2)));
__device__ __forceinline__ unsigned pkbf(float lo, float hi) { f32x2_t v = {lo, hi}; bf16x2_t b = __builtin_convertvector(v, bf16x2_t); return __builtin_bit_cast(unsigned, b); }
__device__ __forceinline__ unsigned pkh(float lo, float hi) { f32x2_t v = {lo, hi}; f16x2_t b = __builtin_convertvector(v, f16x2_t); return __builtin_bit_cast(unsigned, b); }
__device__ __forceinline__ float sigm(float x) { return __builtin_amdgcn_rcpf(1.0f + __builtin_amdgcn_exp2f(-1.4426950408889634f * x)); }
__device__ __forceinline__ float silu(float x) { return x * sigm(x); }

struct EpiInProj {
    static constexpr bool PERM = true, AFTER_DRAIN = false;
    unsigned short* base16; float* misc; const float* lb; size_t arr_stride;
    template <int ACT> __device__ __forceinline__ void store16(const f32x4 (&acc)[2][2][4][2], unsigned short* dst, int row0, const f32x4 (&lbv)[2][2]) const {
#pragma unroll
        for (int ai = 0; ai < 2; ++ai)
#pragma unroll
            for (int m = 0; m < 4; ++m) { unsigned short* rowp = dst + (size_t)(row0 + ai * HALF + m * 16) * 512;
#pragma unroll
                for (int bj = 0; bj < 2; ++bj) { f32x4 v0 = acc[ai][bj][m][0], v1 = acc[ai][bj][m][1]; u32x4 w;
                    if (ACT == 1) {
#pragma unroll
                        for (int e = 0; e < 4; ++e) { v0[e] = silu(v0[e]); v1[e] = silu(v1[e]); } }
                    if (ACT == 2) {
#pragma unroll
                        for (int e = 0; e < 4; ++e) { const float l0 = lbv[bj][0][e], l1 = lbv[bj][1][e];
                            v0[e] = 0.6931471805599453f * __builtin_amdgcn_logf(l0 + (1.0f - l0) * sigm(v0[e]));
                            v1[e] = 0.6931471805599453f * __builtin_amdgcn_logf(l1 + (1.0f - l1) * sigm(v1[e])); }
                        w.x = pkh(v0[0], v0[1]); w.y = pkh(v0[2], v0[3]); w.z = pkh(v1[0], v1[1]); w.w = pkh(v1[2], v1[3]);
                    } else { w.x = pkbf(v0[0], v0[1]); w.y = pkbf(v0[2], v0[3]); w.z = pkbf(v1[0], v1[1]); w.w = pkbf(v1[2], v1[3]); }
                    *(u32x4*)(rowp + bj * HALF) = w; } }
    }
    __device__ __forceinline__ void operator()(const f32x4 (&acc)[2][2][4][2], const Unit& u, int wr, int wc, int fr, int fq) const {
        const int row0 = u.pm * BM + wr * 64 + fr, cb = wc * 32 + 8 * fq;
        if (u.pn == 14) {
#pragma unroll
            for (int ai = 0; ai < 2; ++ai)
#pragma unroll
                for (int m = 0; m < 4; ++m) { float* rowp = misc + (size_t)(row0 + ai * HALF + m * 16) * 256 + cb;
#pragma unroll
                    for (int bj = 0; bj < 2; ++bj) { *(f32x4*)(rowp + bj * HALF) = acc[ai][bj][m][0]; *(f32x4*)(rowp + bj * HALF + 4) = acc[ai][bj][m][1]; } }
            return;
        }
        const int type = u.pn >> 1, ch = (u.pn & 1) * 256 + cb;
        unsigned short* dst = base16 + (size_t)type * arr_stride + ch;
        f32x4 lbv[2][2];
#pragma unroll
        for (int bj = 0; bj < 2; ++bj)
#pragma unroll
            for (int n = 0; n < 2; ++n) lbv[bj][n] = (type == 4) ? *(const f32x4*)(lb + ch + bj * HALF + 4 * n) : (f32x4){0.f, 0.f, 0.f, 0.f};
        if (type == 4) store16<2>(acc, dst, row0, lbv);
        else if (type == 2 || type == 3 || type == 6) store16<1>(acc, dst, row0, lbv);
        else store16<0>(acc, dst, row0, lbv);
    }
};
struct EpiOutRes {
    static constexpr bool PERM = false, AFTER_DRAIN = false;
    const float* x; float* out; float alpha;
    __device__ __forceinline__ void operator()(const f32x4 (&acc)[2][2][4][2], const Unit& u, int wr, int wc, int fr, int fq) const {
        const int row0 = u.pm * BM + wr * 64 + fr, col0 = u.pn * BM + wc * 32 + 4 * fq;
#pragma unroll
        for (int ai = 0; ai < 2; ++ai)
#pragma unroll
            for (int m = 0; m < 4; ++m) { const size_t off = (size_t)(row0 + ai * HALF + m * 16) * 1024 + col0;
#pragma unroll
                for (int bj = 0; bj < 2; ++bj)
#pragma unroll
                    for (int n = 0; n < 2; ++n) { const f32x4 xv = *(const f32x4*)(x + off + bj * HALF + n * 16); *(f32x4*)(out + off + bj * HALF + n * 16) = xv * alpha + acc[ai][bj][m][n]; } }
    }
};

template <class Epi, class Sched, bool ALIGN_EPI = false, bool SP2 = false>
__device__ __forceinline__ void gemm_phase(PG8_LAS unsigned char* lds, const Gemm g, const Sched& S, const Epi& E) {
    const int tid = threadIdx.x, wid = __builtin_amdgcn_readfirstlane(tid >> 6), lane = tid & 63, wr = wid >> 2, wc = wid & 3, fr = lane & 15, fq = lane >> 4;
    const int K = g.K, nt = K / BK;
    unsigned voffA[2], voffB[2];
#pragma unroll
    for (int i = 0; i < 2; ++i) { int R, C; stage_rc(tid * 16 + i * 8192, R, C); const int Rb = Epi::PERM ? ((R & ~31) + perm32(R & 31)) : R;
        voffA[i] = (unsigned)(R * K + C) * 2u; voffB[i] = (unsigned)(Rb * K + C) * 2u; }
    const size_t kstep = (size_t)(BK * 2);
    const size_t hstep = (size_t)HALF * K * 2;
    const size_t tstep = 2 * hstep;
    const unsigned ldsw = (unsigned)wid * 1024u;
    const int aoff = lds_byte(wr * 64 + fr, fq * 8), boff = lds_byte(wc * 32 + fr, fq * 8);
#define PG8_SA(b, h) (((b) * 2 + (h)) * HTB)
#define PG8_SB(b, h) ((4 + (b) * 2 + (h)) * HTB)
#define PG8_STAGE(bufoff, gbase, voff) do { _Pragma("unroll") for (int _i = 0; _i < 2; ++_i) \
        __builtin_amdgcn_global_load_lds((const unsigned*)((const char*)(gbase) + (voff)[_i]), (PG8_LAS unsigned*)(lds + (bufoff) + ldsw + _i * 8192), 16, 0, 0); } while (0)
#define PG8_LDA(dst, b, h) do { _Pragma("unroll") for (int m = 0; m < 4; ++m) _Pragma("unroll") for (int k = 0; k < 2; ++k) dst[m][k] = *(const PG8_LAS bf16x8*)(lds + PG8_SA(b, h) + aoff + m * 2048 + k * 1024); } while (0)
#define PG8_LDB(dst, b, h) do { _Pragma("unroll") for (int n = 0; n < 2; ++n) _Pragma("unroll") for (int k = 0; k < 2; ++k) dst[n][k] = *(const PG8_LAS bf16x8*)(lds + PG8_SB(b, h) + boff + n * 2048 + k * 1024); } while (0)
#define PG8_MMA(ai, bj, At, Bt) do { __builtin_amdgcn_s_setprio(1); _Pragma("unroll") for (int m = 0; m < 4; ++m) _Pragma("unroll") for (int n = 0; n < 2; ++n) _Pragma("unroll") for (int k = 0; k < 2; ++k) \
        acc[ai][bj][m][n] = __builtin_amdgcn_mfma_f32_16x16x32_bf16(Bt[n][k], At[m][k], acc[ai][bj][m][n], 0, 0, 0); __builtin_amdgcn_s_setprio(0); } while (0)
#define PG8_WAIT_V(n) asm volatile("s_waitcnt vmcnt(" #n ")" ::: "memory")
#define PG8_WAIT_L(n) asm volatile("s_waitcnt lgkmcnt(" #n ")" ::: "memory")
#define PG8_BAR __builtin_amdgcn_s_barrier()
#define PG8_SCHED __builtin_amdgcn_sched_barrier(0)
    Unit cur, nxt; int ui = 0;
    if (!S.next(0, cur)) return;
    f32x4 acc[2][2][4][2];
#pragma unroll
    for (int a = 0; a < 2; ++a)
#pragma unroll
        for (int b = 0; b < 2; ++b)
#pragma unroll
            for (int m = 0; m < 4; ++m)
#pragma unroll
                for (int n = 0; n < 2; ++n) acc[a][b][m][n] = (f32x4){0.f, 0.f, 0.f, 0.f};
    bf16x8 At[4][2], B0[2][2], B1[2][2];
    const char* cA = (const char*)g.A + (size_t)cur.pm * tstep; const char* cB = (const char*)g.Bt + (size_t)cur.pn * tstep;
    S.a_ready(cur);
    if constexpr (SP2) {
        PG8_STAGE(PG8_SB(0, 0), cB, voffB); PG8_STAGE(PG8_SB(0, 1), cB + hstep, voffB); PG8_STAGE(PG8_SA(0, 0), cA, voffA); PG8_STAGE(PG8_SA(0, 1), cA + hstep, voffA);
        if (wr == 1) PG8_BAR;
        PG8_WAIT_V(2); PG8_BAR;
        PG8_STAGE(PG8_SB(1, 0), cB + kstep, voffB); PG8_STAGE(PG8_SA(1, 0), cA + kstep, voffA); PG8_STAGE(PG8_SB(1, 1), cB + hstep + kstep, voffB);
        PG8_WAIT_V(6); PG8_BAR;
    } else {
        PG8_STAGE(PG8_SB(0, 0), cB, voffB); PG8_STAGE(PG8_SA(0, 0), cA, voffA); PG8_STAGE(PG8_SB(0, 1), cB + hstep, voffB); PG8_STAGE(PG8_SA(0, 1), cA + hstep, voffA);
        if (wr == 1) PG8_BAR;
        PG8_WAIT_V(4); PG8_BAR;
        PG8_STAGE(PG8_SB(1, 0), cB + kstep, voffB); PG8_STAGE(PG8_SA(1, 0), cA + kstep, voffA); PG8_STAGE(PG8_SB(1, 1), cB + hstep + kstep, voffB);
        PG8_WAIT_V(6); PG8_BAR;
    }
    for (;;) {
        const bool has_next = S.next(ui + 1, nxt);
        const char* nA = has_next ? (const char*)g.A + (size_t)nxt.pm * tstep : cA; const char* nB = has_next ? (const char*)g.Bt + (size_t)nxt.pn * tstep : cB;
        for (int t = 0; t < nt; t += 2) {
            const bool last = (t == nt - 2);
            const char* a1 = cA + (size_t)(t + 1) * kstep;
            const char* a2 = last ? nA : cA + (size_t)(t + 2) * kstep; const char* b2 = last ? nB : cB + (size_t)(t + 2) * kstep;
            const char* a3 = a2 + kstep; const char* b3 = b2 + kstep;
            if (last && has_next) S.a_ready(nxt);
            if constexpr (SP2) {
            PG8_LDB(B0, 0, 0); PG8_LDB(B1, 0, 1); PG8_SCHED; PG8_LDA(At, 0, 0); PG8_STAGE(PG8_SA(1, 1), a1 + hstep, voffA);
            PG8_WAIT_V(8); PG8_WAIT_L(0); PG8_BAR; PG8_MMA(0, 0, At, B0); PG8_MMA(0, 1, At, B1); PG8_BAR; PG8_SCHED;
            PG8_LDA(At, 0, 1); PG8_STAGE(PG8_SB(0, 0), b2, voffB); PG8_STAGE(PG8_SB(0, 1), b2 + hstep, voffB); PG8_STAGE(PG8_SA(0, 0), a2, voffA);
            PG8_WAIT_V(8); PG8_WAIT_L(0); PG8_BAR; PG8_MMA(1, 0, At, B0); PG8_MMA(1, 1, At, B1); PG8_BAR; PG8_SCHED;
            PG8_LDB(B0, 1, 0); PG8_LDB(B1, 1, 1); PG8_SCHED; PG8_LDA(At, 1, 0); PG8_STAGE(PG8_SA(0, 1), a2 + hstep, voffA);
            PG8_WAIT_V(8); PG8_WAIT_L(0); PG8_BAR; PG8_MMA(0, 0, At, B0); PG8_MMA(0, 1, At, B1); PG8_BAR; PG8_SCHED;
            PG8_LDA(At, 1, 1); PG8_STAGE(PG8_SB(1, 0), b3, voffB); PG8_STAGE(PG8_SB(1, 1), b3 + hstep, voffB); PG8_STAGE(PG8_SA(1, 0), a3, voffA);
            PG8_WAIT_V(8); PG8_WAIT_L(0); PG8_BAR; PG8_MMA(1, 0, At, B0); PG8_MMA(1, 1, At, B1); PG8_BAR; PG8_SCHED;
            } else {
            PG8_LDB(B0, 0, 0); PG8_SCHED; PG8_LDA(At, 0, 0); PG8_STAGE(PG8_SA(1, 1), a1 + hstep, voffA);
            PG8_WAIT_L(8); PG8_BAR; PG8_WAIT_L(0); PG8_MMA(0, 0, At, B0); PG8_BAR; PG8_SCHED;
            PG8_LDB(B1, 0, 1); PG8_STAGE(PG8_SB(0, 0), b2, voffB);
            PG8_BAR; PG8_WAIT_L(0); PG8_MMA(0, 1, At, B1); PG8_BAR;
            PG8_LDA(At, 0, 1); PG8_STAGE(PG8_SA(0, 0), a2, voffA);
            PG8_BAR; PG8_WAIT_L(0); PG8_MMA(1, 0, At, B0); PG8_BAR; PG8_SCHED;
            PG8_STAGE(PG8_SB(0, 1), b2 + hstep, voffB);
            PG8_WAIT_V(6); PG8_BAR; PG8_MMA(1, 1, At, B1); PG8_BAR;
            PG8_LDB(B0, 1, 0); PG8_SCHED; PG8_LDA(At, 1, 0); PG8_STAGE(PG8_SA(0, 1), a2 + hstep, voffA);
            PG8_WAIT_L(8); PG8_BAR; PG8_WAIT_L(0); PG8_MMA(0, 0, At, B0); PG8_BAR; PG8_SCHED;
            PG8_LDB(B1, 1, 1); PG8_STAGE(PG8_SB(1, 0), b3, voffB);
            PG8_BAR; PG8_WAIT_L(0); PG8_MMA(0, 1, At, B1); PG8_BAR;
            PG8_LDA(At, 1, 1); PG8_STAGE(PG8_SA(1, 0), a3, voffA);
            PG8_BAR; PG8_WAIT_L(0); PG8_MMA(1, 0, At, B0); PG8_BAR; PG8_SCHED;
            PG8_STAGE(PG8_SB(1, 1), b3 + hstep, voffB);
            PG8_WAIT_V(6); PG8_BAR; PG8_MMA(1, 1, At, B1); PG8_BAR;
            }
        }
        if constexpr (ALIGN_EPI) { if (wr == 0) PG8_BAR; }
        if constexpr (!Epi::AFTER_DRAIN) { E(acc, cur, wr, wc, fr, fq); S.done(cur); }
        if (!has_next) break;
#pragma unroll
        for (int a = 0; a < 2; ++a)
#pragma unroll
            for (int b = 0; b < 2; ++b)
#pragma unroll
                for (int m = 0; m < 4; ++m)
#pragma unroll
                    for (int n = 0; n < 2; ++n) acc[a][b][m][n] = (f32x4){0.f, 0.f, 0.f, 0.f};
        cur = nxt; cA = nA; cB = nB; ++ui;
        if constexpr (ALIGN_EPI) { if (wr == 1) PG8_BAR; }
    }
    PG8_WAIT_V(0);
    if constexpr (!ALIGN_EPI) { if (wr == 0) PG8_BAR; }
    PG8_BAR;
    if constexpr (Epi::AFTER_DRAIN) { E.fused(acc, cur, wr, wc, fr, fq, lds, wid, lane); S.done(cur); }
#undef PG8_SA
#undef PG8_SB
#undef PG8_STAGE
#undef PG8_LDA
#undef PG8_LDB
#undef PG8_MMA
#undef PG8_WAIT_V
#undef PG8_WAIT_L
#undef PG8_BAR
#undef PG8_SCHED
}
}

constexpr size_t MiB = 1u << 20;
constexpr size_t WS_CTL = 0;
constexpr size_t WS_WTIN = 2 * MiB;
constexpr size_t WS_WTO = 10 * MiB;
constexpr size_t WS_LB = 12 * MiB;
constexpr size_t WS_WUVP = 13 * MiB;
constexpr size_t WS_XB = 16 * MiB;
constexpr size_t WS_MIX = 16 * MiB;
constexpr size_t WS_H16 = 80 * MiB;
constexpr size_t H16_STRIDE = (size_t)T_TOK * 512;
constexpr size_t WS_MISC = 304 * MiB;
constexpr size_t WS_CN = 336 * MiB;
constexpr size_t WS_IKB = 344 * MiB;
constexpr size_t WS_IWF = 348 * MiB;
constexpr size_t WS_OB = 352 * MiB;
constexpr size_t WS_OLAT = 416 * MiB;
constexpr size_t WS_END = 480 * MiB;

typedef unsigned short bf16;
typedef unsigned v4u __attribute__((ext_vector_type(4)));
typedef float f32x4 __attribute__((ext_vector_type(4)));
__device__ __forceinline__ float bf2f(unsigned short b) { return __uint_as_float((unsigned)b << 16); }
__device__ __forceinline__ float h2f(unsigned short b) { return (float)__builtin_bit_cast(_Float16, b); }
__device__ __forceinline__ float wave_sum(float v) {
#pragma unroll
    for (int o = 1; o < 64; o <<= 1) v += __shfl_xor(v, o);
    return v;
}
__device__ __forceinline__ float wave_max(float v) {
#pragma unroll
    for (int o = 1; o < 64; o <<= 1) v = fmaxf(v, __shfl_xor(v, o));
    return v;
}

struct Args { const float* in[11]; float* out; unsigned char* ws; };

__device__ __forceinline__ int src_col(int n) {
    if (n < 1024) return 640 + (n - 512);
    if (n < 1536) return 1224 + (n - 1024);
    if (n < 2048) return 1736 + (n - 1536);
    if (n < 2560) return 2248 + (n - 2048);
    if (n < 3072) return 2760 + (n - 2560);
    if (n < 3584) return 3272 + (n - 3072);
    if (n < 3712) return 512 + (n - 3584);
    if (n < 3776) return 1152 + (n - 3712);
    return 1216 + (n - 3776);
}

__device__ __forceinline__ void p0_prep(const Args& a, long gtid, long gsize) {
    const float* x = a.in[0]; const float* w_in = a.in[1]; const float* w_uk = a.in[2]; const float* lbl = a.in[6]; const float* w_o = a.in[8];
    bf16* XB = (bf16*)(a.ws + WS_XB); bf16* WTIN = (bf16*)(a.ws + WS_WTIN); bf16* WTO = (bf16*)(a.ws + WS_WTO); float* LB = (float*)(a.ws + WS_LB);
    constexpr long I_W = (long)NPROJ * 128, I_O = 1024L * 128, I_LB = 512, I_UV = 4 * 128 * 16, I_X = (long)T_TOK * DM / 8;
    const float* w_uv = a.in[3]; bf16* WUVP = (bf16*)(a.ws + WS_WUVP);
    for (long i = gtid; i < I_UV; i += gsize) {
        const int pg = (int)(i & 15), v = (int)((i >> 4) & 127), h = (int)(i >> 11), pos0 = 8 * pg, rb = pos0 >> 5, s = (pos0 >> 4) & 1, hh = (pos0 >> 3) & 1; float t[8];
#pragma unroll
        for (int j = 0; j < 8; ++j) { const int r = 32 * rb + 16 * s + 8 * (j >> 2) + 4 * hh + (j & 3); t[j] = w_uv[(size_t)(h * 128 + r) * 128 + v]; }
        v4u o; o.x = pg8::pkbf(t[0], t[1]); o.y = pg8::pkbf(t[2], t[3]); o.z = pg8::pkbf(t[4], t[5]); o.w = pg8::pkbf(t[6], t[7]);
        *(v4u*)(WUVP + ((size_t)(h * 128 + v)) * 128 + pos0) = o;
    }
    for (long i = gtid; i < I_W + I_O + I_LB + I_X; i += gsize) {
        if (i < I_W) {
            const int n = (int)(i % NPROJ), k0 = (int)(i / NPROJ) * 8; float v[8];
            if (n < 512) {
                const int h = n >> 7, r = n & 127;
#pragma unroll
                for (int j = 0; j < 8; ++j) v[j] = 0.f;
                for (int d = 0; d < 128; ++d) { const float wu = w_uk[(h * 128 + d) * 128 + r];
#pragma unroll
                    for (int j = 0; j < 8; ++j) v[j] += w_in[(size_t)(k0 + j) * DIN + h * 128 + d] * wu; }
#pragma unroll
                for (int j = 0; j < 8; ++j) v[j] *= QSCALE;
            } else if (n < DIN) { const int sc = src_col(n);
#pragma unroll
                for (int j = 0; j < 8; ++j) v[j] = w_in[(size_t)(k0 + j) * DIN + sc];
            } else {
#pragma unroll
                for (int j = 0; j < 8; ++j) v[j] = 0.f;
            }
            v4u o; o.x = pg8::pkbf(v[0], v[1]); o.y = pg8::pkbf(v[2], v[3]); o.z = pg8::pkbf(v[4], v[5]); o.w = pg8::pkbf(v[6], v[7]);
            *(v4u*)(WTIN + (size_t)n * DM + k0) = o;
        } else if (i < I_W + I_O) {
            const long ii = i - I_W; const int n = (int)(ii % 1024), k0 = (int)(ii / 1024) * 8; float v[8];
#pragma unroll
            for (int j = 0; j < 8; ++j) v[j] = w_o[(size_t)(k0 + j) * 1024 + n];
            v4u o; o.x = pg8::pkbf(v[0], v[1]); o.y = pg8::pkbf(v[2], v[3]); o.z = pg8::pkbf(v[4], v[5]); o.w = pg8::pkbf(v[6], v[7]);
            *(v4u*)(WTO + (size_t)n * 1024 + k0) = o;
        } else if (i < I_W + I_O + I_LB) {
            const int c = (int)(i - I_W - I_O);
            LB[c] = 1.0f / (1.0f + expf(lbl[512 + c] - lbl[c]));
        } else {
            const long ii = i - I_W - I_O - I_LB;
            const f32x4 p = ((const f32x4*)x)[2 * ii], q = ((const f32x4*)x)[2 * ii + 1];
            v4u o; o.x = pg8::pkbf(p[0], p[1]); o.y = pg8::pkbf(p[2], p[3]); o.z = pg8::pkbf(q[0], q[1]); o.w = pg8::pkbf(q[2], q[3]);
            ((v4u*)XB)[ii] = o;
        }
    }
}

namespace cg = cooperative_groups;
constexpr int NTHR = 512;
constexpr int LDS_BYTES = 155648;

__device__ __forceinline__ void ph_gemm_in(const Args& a, unsigned char* lds) {
    pg8::Gemm g{(const pg8::bf16_t*)(a.ws + WS_XB), (const pg8::bf16_t*)(a.ws + WS_WTIN), T_TOK, NPROJ, DM};
    pg8::StaticOrder S; S.init(T_TOK, NPROJ, (int)gridDim.x, (int)blockIdx.x);
    pg8::EpiInProj E{(unsigned short*)(a.ws + WS_H16), (float*)(a.ws + WS_MISC), (const float*)(a.ws + WS_LB), H16_STRIDE};
    pg8::gemm_phase<pg8::EpiInProj, pg8::StaticOrder, true, true>((PG8_LAS unsigned char*)lds, g, S, E);
}
__device__ __forceinline__ void ph_gemm_out(const Args& a, unsigned char* lds) {
    pg8::Gemm g{(const pg8::bf16_t*)(a.ws + WS_MIX), (const pg8::bf16_t*)(a.ws + WS_WTO), T_TOK, DM, DM};
    pg8::StaticOrder S; S.init(T_TOK, DM, (int)gridDim.x, (int)blockIdx.x);
    pg8::EpiOutRes E{a.in[0], a.out, DN_ALPHA};
    pg8::gemm_phase<pg8::EpiOutRes, pg8::StaticOrder, true, true>((PG8_LAS unsigned char*)lds, g, S, E);
}

__device__ __forceinline__ void ph_post(const Args& a) {
    const float* misc = (const float*)(a.ws + WS_MISC); const float* kvg = a.in[4];
    bf16* CN = (bf16*)(a.ws + WS_CN); bf16* IKB = (bf16*)(a.ws + WS_IKB); float* IWF = (float*)(a.ws + WS_IWF);
    const int lane = threadIdx.x & 63, gw = (blockIdx.x * NTHR + threadIdx.x) >> 6, ngw = (gridDim.x * NTHR) >> 6;
    for (int t = gw; t < T_TOK; t += ngw) {
        const float* row = misc + (size_t)t * 256;
        const float c0 = row[2 * lane], c1 = row[2 * lane + 1];
        const float ms = wave_sum(c0 * c0 + c1 * c1) * (1.0f / 128.0f);
        const float rs = 1.0f / sqrtf(ms + 1e-6f);
        ((unsigned*)CN)[(size_t)t * 64 + lane] = pg8::pkbf(c0 * rs * kvg[2 * lane], c1 * rs * kvg[2 * lane + 1]);
        const float k0 = row[128 + lane]; const float k1 = __shfl_xor(k0, 1);
        if ((lane & 1) == 0) ((unsigned*)IKB)[(size_t)t * 32 + (lane >> 1)] = pg8::pkbf(k0, k1);
        if (lane < 8) IWF[(size_t)t * 8 + lane] = row[192 + lane] * IW_SCALE;
    }
}

typedef short hbf16x8 __attribute__((ext_vector_type(8)));
typedef float hf32x4 __attribute__((ext_vector_type(4)));
constexpr int HG_QP = 272, HG_SP = 144;
constexpr int HL_QT = 0, HL_KT = 17408, HL_KTT = 34816, HL_VT = 53248, HL_P = 57856, HL_SST = 67072, HL_PART = 75776, HL_BM = 77824, HL_BL = 78336, HL_END = 78848;
__device__ __forceinline__ void ph_hgrn(const Args& a, unsigned char* lds) {
    const bf16* BQ = (const bf16*)(a.ws + WS_H16) + 3 * H16_STRIDE; const bf16* BF = (const bf16*)(a.ws + WS_H16) + 4 * H16_STRIDE; const bf16* BI = (const bf16*)(a.ws + WS_H16) + 5 * H16_STRIDE;
    float* OB = (float*)(a.ws + WS_OB);
    const int tid = threadIdx.x, lane = tid & 63, w = tid >> 6, fr = lane & 15, fq = lane >> 4;
    const int k = tid & 127, tq = tid >> 7;
    const int vs_s = tid >> 3, vs_v = (tid & 7) * 4;
    float* part = (float*)(lds + HL_PART); float* bmv = (float*)(lds + HL_BM); float* blv = (float*)(lds + HL_BL);
    for (int item = blockIdx.x; item < NBATCH * 4 * 4; item += gridDim.x) {
        const int b = item >> 4, h = (item >> 2) & 3, vs = item & 3;
        const size_t colq = (size_t)h * 128 + k, colv = (size_t)h * 128 + vs * 32;
        hf32x4 st[2]; st[0] = (hf32x4){0.f, 0.f, 0.f, 0.f}; st[1] = st[0];
        unsigned short gq[16], gf[16]; unsigned long long gv;
        { const size_t tb = (size_t)b * SEQ;
#pragma unroll
          for (int i = 0; i < 16; ++i) { const size_t off = (tb + 16 * tq + i) * 512 + colq; gq[i] = BQ[off]; gf[i] = BF[off]; }
          gv = *(const unsigned long long*)(BI + (tb + vs_s) * 512 + colv + vs_v); }
        for (int n = 0; n < SEQ / 64; ++n) {
            const size_t tb = (size_t)b * SEQ + 64 * n;
            float g[16], c[16]; float run = 0.f;
#pragma unroll
            for (int i = 0; i < 16; ++i) { g[i] = h2f(gf[i]); run += g[i]; c[i] = run; }
            part[tq * 128 + k] = run;
            __syncthreads();
            const float p0 = part[k], p1 = part[128 + k], p2 = part[256 + k], p3 = part[384 + k];
            const float bm = p0 + p1, bl = (p0 + p1) + (p2 + p3);
            const float offs = tq == 0 ? 0.f : tq == 1 ? p0 : tq == 2 ? (p0 + p1) : (p0 + p1) + p2;
            if (tq == 0) { bmv[k] = bm; blv[k] = bl; }
            unsigned short qt[16], kt[16];
#pragma unroll
            for (int i = 0; i < 16; ++i) {
                const float B = offs + c[i];
                const float eq = __builtin_amdgcn_exp2f(fminf(B - bm, 80.f) * LOG2E), ek = __builtin_amdgcn_exp2f(fminf(bm - B, 80.f) * LOG2E);
                const float kk = 1.0f - __builtin_amdgcn_exp2f(g[i] * LOG2E);
                qt[i] = (unsigned short)(pg8::pkbf(bf2f(gq[i]) * eq, 0.f) & 0xffffu); kt[i] = (unsigned short)(pg8::pkbf(kk * ek, 0.f) & 0xffffu);
            }
#pragma unroll
            for (int i = 0; i < 16; ++i) { *(unsigned short*)(lds + HL_QT + (16 * tq + i) * HG_QP + 2 * k) = qt[i]; *(unsigned short*)(lds + HL_KT + (16 * tq + i) * HG_QP + 2 * k) = kt[i]; }
            { v4u w0, w1;
              w0.x = kt[0] | ((unsigned)kt[1] << 16); w0.y = kt[2] | ((unsigned)kt[3] << 16); w0.z = kt[4] | ((unsigned)kt[5] << 16); w0.w = kt[6] | ((unsigned)kt[7] << 16);
              w1.x = kt[8] | ((unsigned)kt[9] << 16); w1.y = kt[10] | ((unsigned)kt[11] << 16); w1.z = kt[12] | ((unsigned)kt[13] << 16); w1.w = kt[14] | ((unsigned)kt[15] << 16);
              *(v4u*)(lds + HL_KTT + k * HG_SP + 32 * tq) = w0; *(v4u*)(lds + HL_KTT + k * HG_SP + 32 * tq + 16) = w1; }
            { *(unsigned short*)(lds + HL_VT + (vs_v + 0) * HG_SP + 2 * vs_s) = (unsigned short)(gv & 0xffffu); *(unsigned short*)(lds + HL_VT + (vs_v + 1) * HG_SP + 2 * vs_s) = (unsigned short)((gv >> 16) & 0xffffu);
              *(unsigned short*)(lds + HL_VT + (vs_v + 2) * HG_SP + 2 * vs_s) = (unsigned short)((gv >> 32) & 0xffffu); *(unsigned short*)(lds + HL_VT + (vs_v + 3) * HG_SP + 2 * vs_s) = (unsigned short)(gv >> 48); }
            if (n + 1 < SEQ / 64) { const size_t tn = tb + 64;
#pragma unroll
                for (int i = 0; i < 16; ++i) { const size_t off = (tn + 16 * tq + i) * 512 + colq; gq[i] = BQ[off]; gf[i] = BF[off]; }
                gv = *(const unsigned long long*)(BI + (tn + vs_s) * 512 + colv + vs_v); }
            __syncthreads();
#pragma unroll
            for (int j = 0; j < 2; ++j) {
                const int ti = 2 * w + j, kb = ti >> 1, vb = ti & 1, kr = 16 * kb + 4 * fq;
                const hf32x4 bm4 = *(const hf32x4*)(bmv + kr), bl4 = *(const hf32x4*)(blv + kr);
                { uint2 o; o.x = pg8::pkbf(st[j][0] * __builtin_amdgcn_exp2f(bm4[0] * LOG2E), st[j][1] * __builtin_amdgcn_exp2f(bm4[1] * LOG2E));
                  o.y = pg8::pkbf(st[j][2] * __builtin_amdgcn_exp2f(bm4[2] * LOG2E), st[j][3] * __builtin_amdgcn_exp2f(bm4[3] * LOG2E));
                  *(uint2*)(lds + HL_SST + (16 * vb + fr) * HG_QP + 2 * kr) = o; }
                hf32x4 kv = (hf32x4){0.f, 0.f, 0.f, 0.f};
#pragma unroll
                for (int ks = 0; ks < 2; ++ks) {
                    const hbf16x8 af = *(const hbf16x8*)(lds + HL_KTT + (16 * kb + fr) * HG_SP + (32 * ks + 8 * fq) * 2);
                    const hbf16x8 bfr = *(const hbf16x8*)(lds + HL_VT + (16 * vb + fr) * HG_SP + (32 * ks + 8 * fq) * 2);
                    kv = __builtin_amdgcn_mfma_f32_16x16x32_bf16(af, bfr, kv, 0, 0, 0);
                }
#pragma unroll
                for (int r = 0; r < 4; ++r) st[j][r] = st[j][r] * __builtin_amdgcn_exp2f(bl4[r] * LOG2E) + kv[r] * __builtin_amdgcn_exp2f((bl4[r] - bm4[r]) * LOG2E);
                const int sb = ti >> 2, tk = ti & 3;
                hf32x4 sc = (hf32x4){0.f, 0.f, 0.f, 0.f};
                if (tk >= sb) {
#pragma unroll
                    for (int ks = 0; ks < 4; ++ks) {
                        const hbf16x8 af = *(const hbf16x8*)(lds + HL_KT + (16 * sb + fr) * HG_QP + (32 * ks + 8 * fq) * 2);
                        const hbf16x8 bfr = *(const hbf16x8*)(lds + HL_QT + (16 * tk + fr) * HG_QP + (32 * ks + 8 * fq) * 2);
                        sc = __builtin_amdgcn_mfma_f32_16x16x32_bf16(af, bfr, sc, 0, 0, 0);
                    }
                    if (tk == sb) {
#pragma unroll
                        for (int r = 0; r < 4; ++r) if (4 * fq + r > fr) sc[r] = 0.f;
                    }
                }
                { uint2 o; o.x = pg8::pkbf(sc[0], sc[1]); o.y = pg8::pkbf(sc[2], sc[3]); *(uint2*)(lds + HL_P + (16 * tk + fr) * HG_SP + (16 * sb + 4 * fq) * 2) = o; }
            }
            __syncthreads();
            { const int vb2 = w & 1, tk2 = w >> 1; hf32x4 o = (hf32x4){0.f, 0.f, 0.f, 0.f};
#pragma unroll
              for (int ks = 0; ks < 2; ++ks) {
                  const hbf16x8 af = *(const hbf16x8*)(lds + HL_VT + (16 * vb2 + fr) * HG_SP + (32 * ks + 8 * fq) * 2);
                  const hbf16x8 bfr = *(const hbf16x8*)(lds + HL_P + (16 * tk2 + fr) * HG_SP + (32 * ks + 8 * fq) * 2);
                  o = __builtin_amdgcn_mfma_f32_16x16x32_bf16(af, bfr, o, 0, 0, 0);
              }
#pragma unroll
              for (int ks = 0; ks < 4; ++ks) {
                  const hbf16x8 af = *(const hbf16x8*)(lds + HL_SST + (16 * vb2 + fr) * HG_QP + (32 * ks + 8 * fq) * 2);
                  const hbf16x8 bfr = *(const hbf16x8*)(lds + HL_QT + (16 * tk2 + fr) * HG_QP + (32 * ks + 8 * fq) * 2);
                  o = __builtin_amdgcn_mfma_f32_16x16x32_bf16(af, bfr, o, 0, 0, 0);
              }
              *(hf32x4*)(OB + (tb + 16 * tk2 + fr) * 512 + colv + 16 * vb2 + 4 * fq) = o; }
        }
        __syncthreads();
    }
}

typedef float f32x16 __attribute__((ext_vector_type(16)));
typedef short s16x4 __attribute__((ext_vector_type(4)));
typedef short v4i16_t __attribute__((ext_vector_type(4)));
#define LAS __attribute__((address_space(3)))
constexpr int SC_PITCH = 2052;
constexpr int DL_SC = 0, DL_K0 = 0, DL_K1 = 16384, DL_MASK = 16 * SC_PITCH * 4  , DL_BTAB = DL_MASK + 16384  , DL_END = DL_BTAB + 4 * 320 * 4  ;
constexpr float SM_THR = 4.0f;

__device__ __forceinline__ int t5_bucket(int rel) {
    const int n = rel < 0 ? -rel : rel; int bk;
    if (n < 8) bk = n; else bk = 8 + (n >= 13) + (n >= 20) + (n >= 30) + (n >= 46) + (n >= 70) + (n >= 108) + (n >= 166);
    return bk + (rel > 0 ? 16 : 0);
}
__device__ __forceinline__ int fkey(float f) { const int b = __float_as_int(f); return b ^ ((b >> 31) & 0x7fffffff); }
__device__ __forceinline__ unsigned koff(unsigned row, unsigned ch) { return 256u * row + 16u * (ch ^ (((row & 3u) << 2) | ((row >> 2) & 3u))); }
__device__ __forceinline__ float xhalf(float v) { return __shfl_xor(v, 32); }

template <int NREG> __device__ __forceinline__ void select_q(const LAS float* row, int nreg, LAS unsigned long long* mrow, int lane) {
    int v[NREG];
#pragma unroll
    for (int j = 0; j < NREG; ++j) v[j] = (j < nreg) ? fkey(row[64 * j + lane]) : (int)0x80000000;
    long long lo = (long long)(int)0x80000000, hi = 0x7fffffffLL; int thr = 0, cnt_hi = 0; bool exact = false;
    for (;;) {
        if (hi - lo <= 1) break;
        const int mid = (int)(lo + (hi - lo) / 2); int cnt = 0;
#pragma unroll
        for (int j = 0; j < NREG; ++j) cnt += __builtin_popcountll(__ballot(v[j] > mid));
        if (cnt == 256) { thr = mid; exact = true; break; }
        if (cnt > 256) lo = mid; else { hi = mid; cnt_hi = cnt; }
    }
    unsigned long long mine = 0ull;
    if (exact) {
#pragma unroll
        for (int j = 0; j < NREG; ++j) { const unsigned long long bal = __ballot(v[j] > thr); if (lane == j) mine = bal; }
    } else {
        const int vk = (int)hi; int before = 0; const int need = 256 - cnt_hi;
        const unsigned long long ltmask = (1ull << lane) - 1ull;
#pragma unroll
        for (int j = 0; j < NREG; ++j) {
            const unsigned long long eqm = __ballot(v[j] == vk);
            const int rank = before + __builtin_popcountll(eqm & ltmask);
            const bool s = (v[j] > vk) || (v[j] == vk && rank < need);
            const unsigned long long bal = __ballot(s); before += __builtin_popcountll(eqm);
            if (lane == j) mine = bal;
        }
    }
    if (lane < 32) mrow[lane] = mine;
}

__device__ __forceinline__ void ph_mixb(const Args& a) {
    const float* OB = (const float*)(a.ws + WS_OB); const float* hg = a.in[7];
    const bf16* BG = (const bf16*)(a.ws + WS_H16) + 6 * H16_STRIDE; bf16* MIX = (bf16*)(a.ws + WS_MIX);
    const int lane = threadIdx.x & 63, gw = (blockIdx.x * NTHR + threadIdx.x) >> 6, ngw = (gridDim.x * NTHR) >> 6;
    const f32x4 g0 = ((const f32x4*)hg)[2 * lane], g1 = ((const f32x4*)hg)[2 * lane + 1];
    for (int t = gw; t < T_TOK; t += ngw) {
        const f32x4 x0 = ((const f32x4*)(OB + (size_t)t * 512))[2 * lane], x1 = ((const f32x4*)(OB + (size_t)t * 512))[2 * lane + 1];
        const v4u gb = ((const v4u*)(BG + (size_t)t * 512))[lane];
        float ss = (x0[0] * x0[0] + x0[1] * x0[1]) + (x0[2] * x0[2] + x0[3] * x0[3]) + (x1[0] * x1[0] + x1[1] * x1[1]) + (x1[2] * x1[2] + x1[3] * x1[3]);
        ss += __shfl_xor(ss, 1); ss += __shfl_xor(ss, 2); ss += __shfl_xor(ss, 4); ss += __shfl_xor(ss, 8);
        const float rs = 1.0f / sqrtf(ss * (1.0f / 128.0f) + 1e-6f);
        v4u o;
        o.x = pg8::pkbf(x0[0] * rs * g0[0] * __uint_as_float(gb.x << 16), x0[1] * rs * g0[1] * __uint_as_float(gb.x & 0xffff0000u));
        o.y = pg8::pkbf(x0[2] * rs * g0[2] * __uint_as_float(gb.y << 16), x0[3] * rs * g0[3] * __uint_as_float(gb.y & 0xffff0000u));
        o.z = pg8::pkbf(x1[0] * rs * g1[0] * __uint_as_float(gb.z << 16), x1[1] * rs * g1[1] * __uint_as_float(gb.z & 0xffff0000u));
        o.w = pg8::pkbf(x1[2] * rs * g1[2] * __uint_as_float(gb.w << 16), x1[3] * rs * g1[3] * __uint_as_float(gb.w & 0xffff0000u));
        ((v4u*)(MIX + (size_t)t * 1024 + 512))[lane] = o;
    }
}

__device__ __forceinline__ void ph_dsa(const Args& a, unsigned char* lds_g) {
    const bf16* QL = (const bf16*)(a.ws + WS_H16); const bf16* IQ = (const bf16*)(a.ws + WS_H16) + 1 * H16_STRIDE; const bf16* AG = (const bf16*)(a.ws + WS_H16) + 2 * H16_STRIDE;
    const bf16* CN = (const bf16*)(a.ws + WS_CN); const bf16* IKB = (const bf16*)(a.ws + WS_IKB); const float* IWF = (const float*)(a.ws + WS_IWF);
    const bf16* WUVP = (const bf16*)(a.ws + WS_WUVP); const float* rel_bias = a.in[5]; bf16* MIX = (bf16*)(a.ws + WS_MIX);
    LAS unsigned char* lds = (LAS unsigned char*)lds_g;
    const int tid = threadIdx.x, lane = tid & 63, w = __builtin_amdgcn_readfirstlane(tid >> 6);
    LAS float* btab = (LAS float*)(lds + DL_BTAB);
    for (int i = tid; i < 4 * 320; i += NTHR) { const int h = i / 320, ii = i - h * 320; btab[i] = (ii < 319) ? LOG2E * rel_bias[t5_bucket(ii - 255) * 4 + h] : 0.f; }
    const int bx = blockIdx.x, bat = (bx & 7) * 2 + ((bx >> 3) >> 4), pr = (bx >> 3) & 15;
    if (gridDim.x != 256) return;
    const int ql = lane & 31, hi = lane >> 5, hd = w & 3, rg = w >> 2;
    const unsigned xr = ((ql & 3) << 2) | ((ql >> 2) & 3);
    unsigned arow[8];
#pragma unroll
    for (int s = 0; s < 8; ++s) arow[s] = 256u * ql + 16u * ((unsigned)(2 * s + hi) ^ xr);
    const unsigned q4 = (lane & 15) >> 2, p4 = lane & 3, blk = (lane >> 4) & 1, l2 = 2 * blk + (p4 >> 1);
    unsigned vadr[2][4];
#pragma unroll
    for (int t = 0; t < 2; ++t)
#pragma unroll
        for (int c4 = 0; c4 < 4; ++c4) vadr[t][c4] = 256u * (8 * t + 4 * hi + q4) + 64u * ((unsigned)c4 ^ q4) + 16u * (l2 ^ (unsigned)((2 * t + hi) & 3)) + 8u * (p4 & 1);
    const float cbias = LOG2E * rel_bias[15 * 4 + hd];
    const int fr = lane & 15, fq = lane >> 4;

    for (int cc = 0; cc < 2; ++cc) {
        const int c = cc == 0 ? 31 - pr : pr, nk = 64 * (c + 1);
        const size_t tok0 = (size_t)bat * SEQ + 64 * c;
        const size_t key0 = (size_t)bat * SEQ;
        __syncthreads();
        LAS unsigned long long* mask = (LAS unsigned long long*)(lds + DL_MASK);
        if (c <= 3) {
            for (int i = tid; i < 64 * 32; i += NTHR) mask[i] = ((i & 31) <= c) ? ~0ull : 0ull;
        } else {
            for (int sub = 0; sub < 4; ++sub) {
                const size_t tq = tok0 + 16 * sub + fr;
                pg8::bf16x8 iqf[8][2];
#pragma unroll
                for (int h = 0; h < 8; ++h)
#pragma unroll
                    for (int ks = 0; ks < 2; ++ks) iqf[h][ks] = *(const pg8::bf16x8*)(IQ + tq * 512 + h * 64 + 32 * ks + 8 * fq);
                const f32x4 wv0 = *(const f32x4*)(IWF + tq * 8), wv1 = *(const f32x4*)(IWF + tq * 8 + 4);
                LAS float* sc = (LAS float*)(lds + DL_SC);
                for (int kt = w; kt < nk / 16; kt += 8) {
                    const bf16* kp = IKB + (key0 + 16 * kt + fr) * 64 + 8 * fq;
                    const pg8::bf16x8 k0 = *(const pg8::bf16x8*)kp, k1 = *(const pg8::bf16x8*)(kp + 32);
                    f32x4 s4 = (f32x4){0.f, 0.f, 0.f, 0.f};
#pragma unroll
                    for (int h = 0; h < 8; ++h) {
                        f32x4 acc = (f32x4){0.f, 0.f, 0.f, 0.f};
                        acc = __builtin_amdgcn_mfma_f32_16x16x32_bf16(k0, iqf[h][0], acc, 0, 0, 0);
                        acc = __builtin_amdgcn_mfma_f32_16x16x32_bf16(k1, iqf[h][1], acc, 0, 0, 0);
                        const float wh = h < 4 ? wv0[h & 3] : wv1[h & 3];
#pragma unroll
                        for (int r = 0; r < 4; ++r) s4[r] += wh * fmaxf(acc[r], 0.f);
                    }
#pragma unroll
                    for (int r = 0; r < 4; ++r) s4[r] += 0.0f;
                    *(LAS f32x4*)(sc + fr * SC_PITCH + 16 * kt + 4 * fq) = s4;
                }
                __syncthreads();
#pragma unroll 1
                for (int qi = 0; qi < 2; ++qi) {
                    const int qq = 2 * w + qi; const LAS float* row = sc + qq * SC_PITCH; LAS unsigned long long* mrow = mask + (16 * sub + qq) * 32;
                    if (c < 8) select_q<8>(row, c + 1, mrow, lane); else if (c < 16) select_q<16>(row, c + 1, mrow, lane); else if (c < 24) select_q<24>(row, c + 1, mrow, lane); else select_q<32>(row, c + 1, mrow, lane);
                }
                __syncthreads();
            }
        }
        const size_t tqa = tok0 + 32 * rg + ql;
        pg8::bf16x8 qf[8];
#pragma unroll
        for (int s = 0; s < 8; ++s) qf[s] = *(const pg8::bf16x8*)(QL + tqa * 512 + hd * 128 + 16 * s + 8 * hi);
        f32x16 o[4];
#pragma unroll
        for (int c4 = 0; c4 < 4; ++c4)
#pragma unroll
            for (int r = 0; r < 16; ++r) o[c4][r] = 0.f;
        float m_used = -1e30f, l_run = 0.f;
        const int lr0 = tid >> 4, lch = tid & 15;
        v4u kreg0, kreg1;
        { const bf16* src = CN + (key0 + lr0) * 128 + lch * 8; kreg0 = *(const v4u*)src; kreg1 = *(const v4u*)(src + 32 * 128); }
        *(LAS v4u*)(lds + DL_K0 + koff(lr0, lch)) = kreg0; *(LAS v4u*)(lds + DL_K0 + koff(lr0 + 32, lch)) = kreg1;
        const LAS unsigned long long* mq = mask + (32 * rg + ql) * 32;
        for (int j = 0; j <= c; ++j) {
            const unsigned kb_off = (j & 1) ? DL_K1 : DL_K0, nb_off = (j & 1) ? DL_K0 : DL_K1;
            __syncthreads();
            if (j < c) { const bf16* src = CN + (key0 + 64 * (j + 1) + lr0) * 128 + lch * 8; kreg0 = *(const v4u*)src; kreg1 = *(const v4u*)(src + 32 * 128); }
            const bool nearb = (j >= c - 3);
            f32x16 p0, p1;
            { const float ini = nearb ? 0.f : cbias;
#pragma unroll
              for (int r = 0; r < 16; ++r) { p0[r] = ini; p1[r] = ini; } }
#pragma unroll
            for (int s = 0; s < 8; ++s) {
                const pg8::bf16x8 ka = *(const LAS pg8::bf16x8*)(lds + kb_off + arow[s]), kb = *(const LAS pg8::bf16x8*)(lds + kb_off + 8192 + arow[s]);
                p0 = __builtin_amdgcn_mfma_f32_32x32x16_bf16(ka, qf[s], p0, 0, 0, 0);
                p1 = __builtin_amdgcn_mfma_f32_32x32x16_bf16(kb, qf[s], p1, 0, 0, 0);
            }
            if (nearb) {
                const LAS float* bp = btab + hd * 320 + (64 * (j - c) - 32 * rg - ql + 4 * hi + 255);
#pragma unroll
                for (int r = 0; r < 16; ++r) { p0[r] += bp[(r & 3) + 8 * (r >> 2)]; p1[r] += bp[32 + (r & 3) + 8 * (r >> 2)]; }
            }
            float tmax = fmaxf(p0[0], p1[0]);
#pragma unroll
            for (int r = 1; r < 16; ++r) tmax = fmaxf(tmax, fmaxf(p0[r], p1[r]));
            tmax = fmaxf(tmax, xhalf(tmax));
            if (__any(tmax > m_used + SM_THR)) {
                const float mn = fmaxf(m_used, tmax), al = __builtin_amdgcn_exp2f(m_used - mn);
#pragma unroll
                for (int c4 = 0; c4 < 4; ++c4)
#pragma unroll
                    for (int r = 0; r < 16; ++r) o[c4][r] *= al;
                l_run *= al; m_used = mn;
            }
            const unsigned long long mw = mq[j];
            const int m0 = (int)((unsigned)mw >> (4 * hi)), m1 = (int)((unsigned)(mw >> 32) >> (4 * hi));
#pragma unroll
            for (int r = 0; r < 16; ++r) {
                const int pos = (r & 3) + 8 * (r >> 2);
                const float e0 = __int_as_float(__float_as_int(__builtin_amdgcn_exp2f(p0[r] - m_used)) & __builtin_amdgcn_sbfe(m0, pos, 1));
                const float e1 = __int_as_float(__float_as_int(__builtin_amdgcn_exp2f(p1[r] - m_used)) & __builtin_amdgcn_sbfe(m1, pos, 1));
                l_run += e0 + e1; p0[r] = e0; p1[r] = e1;
            }
            pg8::bf16x8 pf[2][2];
#pragma unroll
            for (int s = 0; s < 2; ++s) {
                v4u x0, x1;
                x0.x = pg8::pkbf(p0[8 * s + 0], p0[8 * s + 1]); x0.y = pg8::pkbf(p0[8 * s + 2], p0[8 * s + 3]); x0.z = pg8::pkbf(p0[8 * s + 4], p0[8 * s + 5]); x0.w = pg8::pkbf(p0[8 * s + 6], p0[8 * s + 7]);
                x1.x = pg8::pkbf(p1[8 * s + 0], p1[8 * s + 1]); x1.y = pg8::pkbf(p1[8 * s + 2], p1[8 * s + 3]); x1.z = pg8::pkbf(p1[8 * s + 4], p1[8 * s + 5]); x1.w = pg8::pkbf(p1[8 * s + 6], p1[8 * s + 7]);
                pf[0][s] = __builtin_bit_cast(pg8::bf16x8, x0); pf[1][s] = __builtin_bit_cast(pg8::bf16x8, x1);
            }
#pragma unroll
            for (int kb = 0; kb < 2; ++kb)
#pragma unroll
                for (int s = 0; s < 2; ++s)
#pragma unroll
                    for (int c4 = 0; c4 < 4; ++c4) {
                        const s16x4 lo4 = __builtin_bit_cast(s16x4, __builtin_amdgcn_ds_read_tr16_b64_v4i16((LAS v4i16_t*)(lds + kb_off + 8192 * kb + 4096 * s + vadr[0][c4])));
                        const s16x4 hi4 = __builtin_bit_cast(s16x4, __builtin_amdgcn_ds_read_tr16_b64_v4i16((LAS v4i16_t*)(lds + kb_off + 8192 * kb + 4096 * s + vadr[1][c4])));
                        const pg8::bf16x8 vf = __builtin_shufflevector(lo4, hi4, 0, 1, 2, 3, 4, 5, 6, 7);
                        o[c4] = __builtin_amdgcn_mfma_f32_32x32x16_bf16(vf, pf[kb][s], o[c4], 0, 0, 0);
                    }
            if (j < c) { *(LAS v4u*)(lds + nb_off + koff(lr0, lch)) = kreg0; *(LAS v4u*)(lds + nb_off + koff(lr0 + 32, lch)) = kreg1; }
        }
        const float linv = 1.0f / (l_run + xhalf(l_run));
        pg8::bf16x8 of[4][2];
#pragma unroll
        for (int rb = 0; rb < 4; ++rb)
#pragma unroll
            for (int s = 0; s < 2; ++s) { v4u x;
                x.x = pg8::pkbf(o[rb][8 * s + 0] * linv, o[rb][8 * s + 1] * linv); x.y = pg8::pkbf(o[rb][8 * s + 2] * linv, o[rb][8 * s + 3] * linv);
                x.z = pg8::pkbf(o[rb][8 * s + 4] * linv, o[rb][8 * s + 5] * linv); x.w = pg8::pkbf(o[rb][8 * s + 6] * linv, o[rb][8 * s + 7] * linv);
                of[rb][s] = __builtin_bit_cast(pg8::bf16x8, x); }
#pragma unroll 1
        for (int vb = 0; vb < 4; ++vb) {
            f32x16 y;
#pragma unroll
            for (int r = 0; r < 16; ++r) y[r] = 0.f;
            const bf16* wp = WUVP + ((size_t)hd * 128 + 32 * vb + ql) * 128 + 8 * hi;
#pragma unroll
            for (int rb = 0; rb < 4; ++rb)
#pragma unroll
                for (int s = 0; s < 2; ++s) { const pg8::bf16x8 wf = *(const pg8::bf16x8*)(wp + 32 * rb + 16 * s); y = __builtin_amdgcn_mfma_f32_32x32x16_bf16(wf, of[rb][s], y, 0, 0, 0); }
#pragma unroll
            for (int g = 0; g < 4; ++g) {
                const size_t col = (size_t)hd * 128 + 32 * vb + 8 * g + 4 * hi;
                const uint2 gt = *(const uint2*)(AG + tqa * 512 + col);
                uint2 ov; ov.x = pg8::pkbf(y[4 * g + 0] * __uint_as_float(gt.x << 16), y[4 * g + 1] * __uint_as_float(gt.x & 0xffff0000u));
                ov.y = pg8::pkbf(y[4 * g + 2] * __uint_as_float(gt.y << 16), y[4 * g + 3] * __uint_as_float(gt.y & 0xffff0000u));
                *(uint2*)(MIX + tqa * 1024 + col) = ov;
            }
        }
    }
    __syncthreads();
}

__device__ __forceinline__ void ph_ln(const Args& a) {
    float* out = a.out; const float* g = a.in[9]; const float* bb = a.in[10];
    const int lane = threadIdx.x & 63, gw = (blockIdx.x * NTHR + threadIdx.x) >> 6, ngw = (gridDim.x * NTHR) >> 6;
    for (int t = gw; t < T_TOK; t += ngw) {
        f32x4* row = (f32x4*)(out + (size_t)t * 1024) + lane; f32x4 v[4]; float s = 0.f;
#pragma unroll
        for (int j = 0; j < 4; ++j) { v[j] = row[64 * j]; s += (v[j][0] + v[j][1]) + (v[j][2] + v[j][3]); }
        const float mean = wave_sum(s) * (1.0f / 1024.0f); float s2 = 0.f;
#pragma unroll
        for (int j = 0; j < 4; ++j) { v[j] = v[j] - mean; s2 += (v[j][0] * v[j][0] + v[j][1] * v[j][1]) + (v[j][2] * v[j][2] + v[j][3] * v[j][3]); }
        const float rstd = 1.0f / sqrtf(wave_sum(s2) * (1.0f / 1024.0f) + 1e-5f);
#pragma unroll
        for (int j = 0; j < 4; ++j) { const f32x4 gv = ((const f32x4*)g)[lane + 64 * j], bv = ((const f32x4*)bb)[lane + 64 * j]; row[64 * j] = v[j] * rstd * gv + bv; }
    }
}

__global__ void __launch_bounds__(NTHR, 2) mk_fwd(Args a) {
    extern __shared__ __attribute__((aligned(16))) unsigned char lds[];
    cg::grid_group grid = cg::this_grid();
    p0_prep(a, (long)blockIdx.x * NTHR + threadIdx.x, (long)gridDim.x * NTHR);
    grid.sync();
    ph_gemm_in(a, lds);
    grid.sync();
    ph_post(a);
    ph_hgrn(a, lds);
    grid.sync();
    ph_mixb(a);
    ph_dsa(a, lds);
    grid.sync();
    ph_gemm_out(a, lds);
    grid.sync();
    ph_ln(a);
}

extern "C" void kernel_launch(void* const* d_in, const int* in_sizes, int n_in, void* d_out, int out_size, void* d_ws, size_t ws_size, hipStream_t stream) {
    static int grid = 0;
    if (grid == 0) {
        if (n_in != 11 || out_size != T_TOK * DM || ws_size < WS_END) { fprintf(stderr, "kernel_launch: unexpected shapes (n_in %d, out %d, ws %zu)\n", n_in, out_size, ws_size); grid = -1; return; }
        if (hipFuncSetAttribute((const void*)mk_fwd, hipFuncAttributeMaxDynamicSharedMemorySize, LDS_BYTES) != hipSuccess) { fprintf(stderr, "kernel_launch: hipFuncSetAttribute failed\n"); grid = -1; return; }
        int dev = 0, cus = 0, per_cu = 0;
        (void)hipGetDevice(&dev); (void)hipDeviceGetAttribute(&cus, hipDeviceAttributeMultiprocessorCount, dev);
        (void)hipOccupancyMaxActiveBlocksPerMultiprocessor(&per_cu, (const void*)mk_fwd, NTHR, LDS_BYTES);
        if (per_cu < 1 || cus < 1) { fprintf(stderr, "kernel_launch: occupancy query says %d blocks/CU on %d CUs\n", per_cu, cus); grid = -1; return; }
        grid = cus;
        fprintf(stderr, "kernel_launch: %d CUs, %d blocks/CU by the occupancy query, grid %d\n", cus, per_cu, grid);
    }
    if (grid < 0) return;
    Args a{};
    for (int i = 0; i < 11; ++i) a.in[i] = (const float*)d_in[i];
    a.out = (float*)d_out; a.ws = (unsigned char*)d_ws;
    void* params[] = {&a};
    hipError_t e = hipLaunchCooperativeKernel((const void*)mk_fwd, dim3(grid), dim3(NTHR), params, LDS_BYTES, stream);
    if (e != hipSuccess) fprintf(stderr, "kernel_launch: cooperative launch failed: %s (grid %d)\n", hipGetErrorString(e), grid);
}
```

```cpp
#include <hip/hip_runtime.h>
#include <cstdio>
#include <cstdint>

constexpr int T_TOK = 32768, DM = 1024, SEQ = 2048, NBATCH = 16, NPROJ = 3840  , DIN = 3784;
constexpr float QSCALE = 0.08838834764831845f * 1.4426950408889634f;
constexpr float LOG2E = 1.4426950408889634f;
constexpr float IW_SCALE = 0.35355339059327373f * 0.125f;
constexpr float DN_ALPHA = 1.189207115002721f;
namespace pg8 {
#define PG8_LAS __attribute__((address_space(3)))
typedef unsigned short bf16_t;
typedef short bf16x8 __attribute__((ext_vector_type(8)));
typedef float f32x4 __attribute__((ext_vector_type(4)));
typedef unsigned u32x4 __attribute__((ext_vector_type(4)));
constexpr int BM = 256, BK = 64, HALF = 128, HTB = HALF * BK * 2  , STAGE_BYTES = 8 * HTB, NXCD = 8, WGM = 8;

__host__ __device__ __forceinline__ int lds_byte(int r, int c) { const int st = (r >> 4) * 2 + (c >> 5), rr = r & 15, cc = c & 31, ob = rr * 64 + cc * 2; return st * 1024 + (ob ^ (((ob >> 9) & 1) << 5)); }
__host__ __device__ __forceinline__ void stage_rc(int b, int& R, int& C) { const int st = b / 1024, sb = b % 1024, swz = sb ^ (((sb >> 9) & 1) << 5); R = (st >> 1) * 16 + swz / 64; C = (st & 1) * 32 + (swz % 64) / 2; }
__host__ __device__ __forceinline__ int perm32(int rho) { const int n = rho >> 4, i = rho & 15; return 8 * (i >> 2) + 4 * n + (i & 3); }

struct Unit { int pm, pn; };
struct Gemm { const bf16_t* A; const bf16_t* Bt; int M, N, K; };

struct StaticOrder {
    int nM, nN, nwg, G, c, rep = 1;
    __host__ __device__ void init(int M, int N, int G_, int c_) { nM = M / BM; nN = N / BM; nwg = nM * nN; G = G_; c = c_; }
    __host__ __device__ bool next(int i, Unit& u) const {
#ifndef PG8_REPEAT
#define PG8_REPEAT 1
#endif
        long L = (long)i * G + c; if (L >= (long)nwg * rep) return false; L %= nwg;
        int wgid = (int)L; { const int q = nwg / NXCD, r = nwg % NXCD, xcd = wgid % NXCD, off = wgid / NXCD; wgid = (xcd < r ? xcd * (q + 1) : r * (q + 1) + (xcd - r) * q) + off; }
        const int nig = WGM * nN, gid = wgid / nig, fm = gid * WGM, gsz = (nM - fm) < WGM ? (nM - fm) : WGM;
        u.pm = fm + ((wgid % nig) % gsz); u.pn = (wgid % nig) / gsz; return true;
    }
    __device__ __forceinline__ void a_ready(const Unit&) const {}
    __device__ __forceinline__ void done(const Unit&) const {}
};

typedef float f32x2_t __attribute__((ext_vector_type(2)));
typedef __bf16 bf16x2_t __attribute__((ext_vector_type(2)));
typedef _Float16 f16x2_t __attribute__((ext_vector_type(2)));
__device__ __forceinline__ unsigned pkbf(float lo, float hi) { f32x2_t v = {lo, hi}; bf16x2_t b = __builtin_convertvector(v, bf16x2_t); return __builtin_bit_cast(unsigned, b); }
__device__ __forceinline__ unsigned pkh(float lo, float hi) { f32x2_t v = {lo, hi}; f16x2_t b = __builtin_convertvector(v, f16x2_t); return __builtin_bit_cast(unsigned, b); }
__device__ __forceinline__ float sigm(float x) { return __builtin_amdgcn_rcpf(1.0f + __builtin_amdgcn_exp2f(-1.4426950408889634f * x)); }
__device__ __forceinline__ float silu(float x) { return x * sigm(x); }

struct EpiInProj {
    static constexpr bool PERM = true, AFTER_DRAIN = false;
    unsigned short* base16; float* misc; const float* lb; size_t arr_stride;
    template <int ACT> __device__ __forceinline__ void store16(const f32x4 (&acc)[2][2][4][2], unsigned short* dst, int row0, const f32x4 (&lbv)[2][2]) const {
#pragma unroll
        for (int ai = 0; ai < 2; ++ai)
#pragma unroll
            for (int m = 0; m < 4; ++m) { unsigned short* rowp = dst + (size_t)(row0 + ai * HALF + m * 16) * 512;
#pragma unroll
                for (int bj = 0; bj < 2; ++bj) { f32x4 v0 = acc[ai][bj][m][0], v1 = acc[ai][bj][m][1]; u32x4 w;
                    if (ACT == 1) {
#pragma unroll
                        for (int e = 0; e < 4; ++e) { v0[e] = silu(v0[e]); v1[e] = silu(v1[e]); } }
                    if (ACT == 2) {
#pragma unroll
                        for (int e = 0; e < 4; ++e) { const float l0 = lbv[bj][0][e], l1 = lbv[bj][1][e];
                            v0[e] = 0.6931471805599453f * __builtin_amdgcn_logf(l0 + (1.0f - l0) * sigm(v0[e]));
                            v1[e] = 0.6931471805599453f * __builtin_amdgcn_logf(l1 + (1.0f - l1) * sigm(v1[e])); }
                        w.x = pkh(v0[0], v0[1]); w.y = pkh(v0[2], v0[3]); w.z = pkh(v1[0], v1[1]); w.w = pkh(v1[2], v1[3]);
                    } else { w.x = pkbf(v0[0], v0[1]); w.y = pkbf(v0[2], v0[3]); w.z = pkbf(v1[0], v1[1]); w.w = pkbf(v1[2], v1[3]); }
                    *(u32x4*)(rowp + bj * HALF) = w; } }
    }
    __device__ __forceinline__ void operator()(const f32x4 (&acc)[2][2][4][2], const Unit& u, int wr, int wc, int fr, int fq) const {
        const int row0 = u.pm * BM + wr * 64 + fr, cb = wc * 32 + 8 * fq;
        if (u.pn == 14) {
#pragma unroll
            for (int ai = 0; ai < 2; ++ai)
#pragma unroll
                for (int m = 0; m < 4; ++m) { float* rowp = misc + (size_t)(row0 + ai * HALF + m * 16) * 256 + cb;
#pragma unroll
                    for (int bj = 0; bj < 2; ++bj) { *(f32x4*)(rowp + bj * HALF) = acc[ai][bj][m][0]; *(f32x4*)(rowp + bj * HALF + 4) = acc[ai][bj][m][1]; } }
            return;
        }
        const int type = u.pn >> 1, ch = (u.pn & 1) * 256 + cb;
        unsigned short* dst = base16 + (size_t)type * arr_stride + ch;
        f32x4 lbv[2][2];
#pragma unroll
        for (int bj = 0; bj < 2; ++bj)
#pragma unroll
            for (int n = 0; n < 2; ++n) lbv[bj][n] = (type == 4) ? *(const f32x4*)(lb + ch + bj * HALF + 4 * n) : (f32x4){0.f, 0.f, 0.f, 0.f};
        if (type == 4) store16<2>(acc, dst, row0, lbv);
        else if (type == 2 || type == 3 || type == 6) store16<1>(acc, dst, row0, lbv);
        else store16<0>(acc, dst, row0, lbv);
    }
};
struct EpiOutRes {
    static constexpr bool PERM = false, AFTER_DRAIN = false;
    const float* x; float* out; float alpha;
    __device__ __forceinline__ void operator()(const f32x4 (&acc)[2][2][4][2], const Unit& u, int wr, int wc, int fr, int fq) const {
        const int row0 = u.pm * BM + wr * 64 + fr, col0 = u.pn * BM + wc * 32 + 4 * fq;
#pragma unroll
        for (int ai = 0; ai < 2; ++ai)
#pragma unroll
            for (int m = 0; m < 4; ++m) { const size_t off = (size_t)(row0 + ai * HALF + m * 16) * 1024 + col0;
#pragma unroll
                for (int bj = 0; bj < 2; ++bj)
#pragma unroll
                    for (int n = 0; n < 2; ++n) { const f32x4 xv = *(const f32x4*)(x + off + bj * HALF + n * 16); *(f32x4*)(out + off + bj * HALF + n * 16) = xv * alpha + acc[ai][bj][m][n]; } }
    }
};

template <class Epi, class Sched, bool ALIGN_EPI = false, bool SP2 = false>
__device__ __forceinline__ void gemm_phase(PG8_LAS unsigned char* lds, const Gemm g, const Sched& S, const Epi& E) {
    const int tid = threadIdx.x, wid = __builtin_amdgcn_readfirstlane(tid >> 6), lane = tid & 63, wr = wid >> 2, wc = wid & 3, fr = lane & 15, fq = lane >> 4;
    const int K = g.K, nt = K / BK;
    unsigned voffA[2], voffB[2];
#pragma unroll
    for (int i = 0; i < 2; ++i) { int R, C; stage_rc(tid * 16 + i * 8192, R, C); const int Rb = Epi::PERM ? ((R & ~31) + perm32(R & 31)) : R;
        voffA[i] = (unsigned)(R * K + C) * 2u; voffB[i] = (unsigned)(Rb * K + C) * 2u; }
    const size_t kstep = (size_t)(BK * 2);
    const size_t hstep = (size_t)HALF * K * 2;
    const size_t tstep = 2 * hstep;
    const unsigned ldsw = (unsigned)wid * 1024u;
    const int aoff = lds_byte(wr * 64 + fr, fq * 8), boff = lds_byte(wc * 32 + fr, fq * 8);
#define PG8_SA(b, h) (((b) * 2 + (h)) * HTB)
#define PG8_SB(b, h) ((4 + (b) * 2 + (h)) * HTB)
#define PG8_STAGE(bufoff, gbase, voff) do { _Pragma("unroll") for (int _i = 0; _i < 2; ++_i) \
        __builtin_amdgcn_global_load_lds((const unsigned*)((const char*)(gbase) + (voff)[_i]), (PG8_LAS unsigned*)(lds + (bufoff) + ldsw + _i * 8192), 16, 0, 0); } while (0)
#define PG8_LDA(dst, b, h) do { _Pragma("unroll") for (int m = 0; m < 4; ++m) _Pragma("unroll") for (int k = 0; k < 2; ++k) dst[m][k] = *(const PG8_LAS bf16x8*)(lds + PG8_SA(b, h) + aoff + m * 2048 + k * 1024); } while (0)
#define PG8_LDB(dst, b, h) do { _Pragma("unroll") for (int n = 0; n < 2; ++n) _Pragma("unroll") for (int k = 0; k < 2; ++k) dst[n][k] = *(const PG8_LAS bf16x8*)(lds + PG8_SB(b, h) + boff + n * 2048 + k * 1024); } while (0)
#define PG8_MMA(ai, bj, At, Bt) do { __builtin_amdgcn_s_setprio(1); _Pragma("unroll") for (int m = 0; m < 4; ++m) _Pragma("unroll") for (int n = 0; n < 2; ++n) _Pragma("unroll") for (int k = 0; k < 2; ++k) \
        acc[ai][bj][m][n] = __builtin_amdgcn_mfma_f32_16x16x32_bf16(Bt[n][k], At[m][k], acc[ai][bj][m][n], 0, 0, 0); __builtin_amdgcn_s_setprio(0); } while (0)
#define PG8_WAIT_V(n) asm volatile("s_waitcnt vmcnt(" #n ")" ::: "memory")
#define PG8_WAIT_L(n) asm volatile("s_waitcnt lgkmcnt(" #n ")" ::: "memory")
#define PG8_BAR __builtin_amdgcn_s_barrier()
#define PG8_SCHED __builtin_amdgcn_sched_barrier(0)
    Unit cur, nxt; int ui = 0;
    if (!S.next(0, cur)) return;
    f32x4 acc[2][2][4][2];
#pragma unroll
    for (int a = 0; a < 2; ++a)
#pragma unroll
        for (int b = 0; b < 2; ++b)
#pragma unroll
            for (int m = 0; m < 4; ++m)
#pragma unroll
                for (int n = 0; n < 2; ++n) acc[a][b][m][n] = (f32x4){0.f, 0.f, 0.f, 0.f};
    bf16x8 At[4][2], B0[2][2], B1[2][2];
    const char* cA = (const char*)g.A + (size_t)cur.pm * tstep; const char* cB = (const char*)g.Bt + (size_t)cur.pn * tstep;
    S.a_ready(cur);
    if constexpr (SP2) {
        PG8_STAGE(PG8_SB(0, 0), cB, voffB); PG8_STAGE(PG8_SB(0, 1), cB + hstep, voffB); PG8_STAGE(PG8_SA(0, 0), cA, voffA); PG8_STAGE(PG8_SA(0, 1), cA + hstep, voffA);
        if (wr == 1) PG8_BAR;
        PG8_WAIT_V(2); PG8_BAR;
        PG8_STAGE(PG8_SB(1, 0), cB + kstep, voffB); PG8_STAGE(PG8_SA(1, 0), cA + kstep, voffA); PG8_STAGE(PG8_SB(1, 1), cB + hstep + kstep, voffB);
        PG8_WAIT_V(6); PG8_BAR;
    } else {
        PG8_STAGE(PG8_SB(0, 0), cB, voffB); PG8_STAGE(PG8_SA(0, 0), cA, voffA); PG8_STAGE(PG8_SB(0, 1), cB + hstep, voffB); PG8_STAGE(PG8_SA(0, 1), cA + hstep, voffA);
        if (wr == 1) PG8_BAR;
        PG8_WAIT_V(4); PG8_BAR;
        PG8_STAGE(PG8_SB(1, 0), cB + kstep, voffB); PG8_STAGE(PG8_SA(1, 0), cA + kstep, voffA); PG8_STAGE(PG8_SB(1, 1), cB + hstep + kstep, voffB);
        PG8_WAIT_V(6); PG8_BAR;
    }
    for (;;) {
        const bool has_next = S.next(ui + 1, nxt);
        const char* nA = has_next ? (const char*)g.A + (size_t)nxt.pm * tstep : cA; const char* nB = has_next ? (const char*)g.Bt + (size_t)nxt.pn * tstep : cB;
        for (int t = 0; t < nt; t += 2) {
            const bool last = (t == nt - 2);
            const char* a1 = cA + (size_t)(t + 1) * kstep;
            const char* a2 = last ? nA : cA + (size_t)(t + 2) * kstep; const char* b2 = last ? nB : cB + (size_t)(t + 2) * kstep;
            const char* a3 = a2 + kstep; const char* b3 = b2 + kstep;
            if (last && has_next) S.a_ready(nxt);
            if constexpr (SP2) {
            PG8_LDB(B0, 0, 0); PG8_LDB(B1, 0, 1); PG8_SCHED; PG8_LDA(At, 0, 0); PG8_STAGE(PG8_SA(1, 1), a1 + hstep, voffA);
            PG8_WAIT_V(8); PG8_WAIT_L(0); PG8_BAR; PG8_MMA(0, 0, At, B0); PG8_MMA(0, 1, At, B1); PG8_BAR; PG8_SCHED;
            PG8_LDA(At, 0, 1); PG8_STAGE(PG8_SB(0, 0), b2, voffB); PG8_STAGE(PG8_SB(0, 1), b2 + hstep, voffB); PG8_STAGE(PG8_SA(0, 0), a2, voffA);
            PG8_WAIT_V(8); PG8_WAIT_L(0); PG8_BAR; PG8_MMA(1, 0, At, B0); PG8_MMA(1, 1, At, B1); PG8_BAR; PG8_SCHED;
            PG8_LDB(B0, 1, 0); PG8_LDB(B1, 1, 1); PG8_SCHED; PG8_LDA(At, 1, 0); PG8_STAGE(PG8_SA(0, 1), a2 + hstep, voffA);
            PG8_WAIT_V(8); PG8_WAIT_L(0); PG8_BAR; PG8_MMA(0, 0, At, B0); PG8_MMA(0, 1, At, B1); PG8_BAR; PG8_SCHED;
            PG8_LDA(At, 1, 1); PG8_STAGE(PG8_SB(1, 0), b3, voffB); PG8_STAGE(PG8_SB(1, 1), b3 + hstep, voffB); PG8_STAGE(PG8_SA(1, 0), a3, voffA);
            PG8_WAIT_V(8); PG8_WAIT_L(0); PG8_BAR; PG8_MMA(1, 0, At, B0); PG8_MMA(1, 1, At, B1); PG8_BAR; PG8_SCHED;
            } else {
            PG8_LDB(B0, 0, 0); PG8_SCHED; PG8_LDA(At, 0, 0); PG8_STAGE(PG8_SA(1, 1), a1 + hstep, voffA);
            PG8_WAIT_L(8); PG8_BAR; PG8_WAIT_L(0); PG8_MMA(0, 0, At, B0); PG8_BAR; PG8_SCHED;
            PG8_LDB(B1, 0, 1); PG8_STAGE(PG8_SB(0, 0), b2, voffB);
            PG8_BAR; PG8_WAIT_L(0); PG8_MMA(0, 1, At, B1); PG8_BAR;
            PG8_LDA(At, 0, 1); PG8_STAGE(PG8_SA(0, 0), a2, voffA);
            PG8_BAR; PG8_WAIT_L(0); PG8_MMA(1, 0, At, B0); PG8_BAR; PG8_SCHED;
            PG8_STAGE(PG8_SB(0, 1), b2 + hstep, voffB);
            PG8_WAIT_V(6); PG8_BAR; PG8_MMA(1, 1, At, B1); PG8_BAR;
            PG8_LDB(B0, 1, 0); PG8_SCHED; PG8_LDA(At, 1, 0); PG8_STAGE(PG8_SA(0, 1), a2 + hstep, voffA);
            PG8_WAIT_L(8); PG8_BAR; PG8_WAIT_L(0); PG8_MMA(0, 0, At, B0); PG8_BAR; PG8_SCHED;
            PG8_LDB(B1, 1, 1); PG8_STAGE(PG8_SB(1, 0), b3, voffB);
            PG8_BAR; PG8_WAIT_L(0); PG8_MMA(0, 1, At, B1); PG8_BAR;
            PG8_LDA(At, 1, 1); PG8_STAGE(PG8_SA(1, 0), a3, voffA);
            PG8_BAR; PG8_WAIT_L(0); PG8_MMA(1, 0, At, B0); PG8_BAR; PG8_SCHED;
            PG8_STAGE(PG8_SB(1, 1), b3 + hstep, voffB);
            PG8_WAIT_V(6); PG8_BAR; PG8_MMA(1, 1, At, B1); PG8_BAR;
            }
        }
        if constexpr (ALIGN_EPI) { if (wr == 0) PG8_BAR; }
        if constexpr (!Epi::AFTER_DRAIN) { E(acc, cur, wr, wc, fr, fq); S.done(cur); }
        if (!has_next) break;
#pragma unroll
        for (int a = 0; a < 2; ++a)
#pragma unroll
            for (int b = 0; b < 2; ++b)
#pragma unroll
                for (int m = 0; m < 4; ++m)
#pragma unroll
                    for (int n = 0; n < 2; ++n) acc[a][b][m][n] = (f32x4){0.f, 0.f, 0.f, 0.f};
        cur = nxt; cA = nA; cB = nB; ++ui;
        if constexpr (ALIGN_EPI) { if (wr == 1) PG8_BAR; }
    }
    PG8_WAIT_V(0);
    if constexpr (!ALIGN_EPI) { if (wr == 0) PG8_BAR; }
    PG8_BAR;
    if constexpr (Epi::AFTER_DRAIN) { E.fused(acc, cur, wr, wc, fr, fq, lds, wid, lane); S.done(cur); }
#undef PG8_SA
#undef PG8_SB
#undef PG8_STAGE
#undef PG8_LDA
#undef PG8_LDB
#undef PG8_MMA
#undef PG8_WAIT_V
#undef PG8_WAIT_L
#undef PG8_BAR
#undef PG8_SCHED
}
}

constexpr size_t MiB = 1u << 20;
constexpr size_t WS_CTL = 0;
constexpr size_t WS_WTIN = 2 * MiB;
constexpr size_t WS_WTO = 10 * MiB;
constexpr size_t WS_LB = 12 * MiB;
constexpr size_t WS_WUVP = 13 * MiB;
constexpr size_t WS_XB = 16 * MiB;
constexpr size_t WS_MIX = 16 * MiB;
constexpr size_t WS_H16 = 80 * MiB;
constexpr size_t H16_STRIDE = (size_t)T_TOK * 512;
constexpr size_t WS_MISC = 304 * MiB;
constexpr size_t WS_CN = 336 * MiB;
constexpr size_t WS_IKB = 344 * MiB;
constexpr size_t WS_IWF = 348 * MiB;
constexpr size_t WS_OB = 352 * MiB;
constexpr size_t WS_OLAT = 416 * MiB;
constexpr size_t WS_END = 480 * MiB;

typedef unsigned short bf16;
typedef unsigned v4u __attribute__((ext_vector_type(4)));
typedef float f32x4 __attribute__((ext_vector_type(4)));
__device__ __forceinline__ float bf2f(unsigned short b) { return __uint_as_float((unsigned)b << 16); }
__device__ __forceinline__ float h2f(unsigned short b) { return (float)__builtin_bit_cast(_Float16, b); }
__device__ __forceinline__ float wave_sum(float v) {
#pragma unroll
    for (int o = 1; o < 64; o <<= 1) v += __shfl_xor(v, o);
    return v;
}
__device__ __forceinline__ float wave_max(float v) {
#pragma unroll
    for (int o = 1; o < 64; o <<= 1) v = fmaxf(v, __shfl_xor(v, o));
    return v;
}

struct Args { const float* in[11]; float* out; unsigned char* ws; };

__device__ __forceinline__ int src_col(int n) {
    if (n < 1024) return 640 + (n - 512);
    if (n < 1536) return 1224 + (n - 1024);
    if (n < 2048) return 1736 + (n - 1536);
    if (n < 2560) return 2248 + (n - 2048);
    if (n < 3072) return 2760 + (n - 2560);
    if (n < 3584) return 3272 + (n - 3072);
    if (n < 3712) return 512 + (n - 3584);
    if (n < 3776) return 1152 + (n - 3712);
    return 1216 + (n - 3776);
}

__device__ __forceinline__ void p0_prep(const Args& a, long gtid, long gsize) {
    const float* x = a.in[0]; const float* w_in = a.in[1]; const float* w_uk = a.in[2]; const float* lbl = a.in[6]; const float* w_o = a.in[8];
    bf16* XB = (bf16*)(a.ws + WS_XB); bf16* WTIN = (bf16*)(a.ws + WS_WTIN); bf16* WTO = (bf16*)(a.ws + WS_WTO); float* LB = (float*)(a.ws + WS_LB);
    constexpr long I_W = (long)NPROJ * 128, I_O = 1024L * 128, I_LB = 512, I_UV = 4 * 128 * 16, I_X = (long)T_TOK * DM / 8;
    const float* w_uv = a.in[3]; bf16* WUVP = (bf16*)(a.ws + WS_WUVP);
    for (long i = gtid; i < I_UV; i += gsize) {
        const int pg = (int)(i & 15), v = (int)((i >> 4) & 127), h = (int)(i >> 11), pos0 = 8 * pg, rb = pos0 >> 5, s = (pos0 >> 4) & 1, hh = (pos0 >> 3) & 1; float t[8];
#pragma unroll
        for (int j = 0; j < 8; ++j) { const int r = 32 * rb + 16 * s + 8 * (j >> 2) + 4 * hh + (j & 3); t[j] = w_uv[(size_t)(h * 128 + r) * 128 + v]; }
        v4u o; o.x = pg8::pkbf(t[0], t[1]); o.y = pg8::pkbf(t[2], t[3]); o.z = pg8::pkbf(t[4], t[5]); o.w = pg8::pkbf(t[6], t[7]);
        *(v4u*)(WUVP + ((size_t)(h * 128 + v)) * 128 + pos0) = o;
    }
    for (long i = gtid; i < I_W + I_O + I_LB + I_X; i += gsize) {
        if (i < I_W) {
            const int n = (int)(i % NPROJ), k0 = (int)(i / NPROJ) * 8; float v[8];
            if (n < 512) {
                const int h = n >> 7, r = n & 127;
#pragma unroll
                for (int j = 0; j < 8; ++j) v[j] = 0.f;
                for (int d = 0; d < 128; ++d) { const float wu = w_uk[(h * 128 + d) * 128 + r];
#pragma unroll
                    for (int j = 0; j < 8; ++j) v[j] += w_in[(size_t)(k0 + j) * DIN + h * 128 + d] * wu; }
#pragma unroll
                for (int j = 0; j < 8; ++j) v[j] *= QSCALE;
            } else if (n < DIN) { const int sc = src_col(n);
#pragma unroll
                for (int j = 0; j < 8; ++j) v[j] = w_in[(size_t)(k0 + j) * DIN + sc];
            } else {
#pragma unroll
                for (int j = 0; j < 8; ++j) v[j] = 0.f;
            }
            v4u o; o.x = pg8::pkbf(v[0], v[1]); o.y = pg8::pkbf(v[2], v[3]); o.z = pg8::pkbf(v[4], v[5]); o.w = pg8::pkbf(v[6], v[7]);
            *(v4u*)(WTIN + (size_t)n * DM + k0) = o;
        } else if (i < I_W + I_O) {
            const long ii = i - I_W; const int n = (int)(ii % 1024), k0 = (int)(ii / 1024) * 8; float v[8];
#pragma unroll
            for (int j = 0; j < 8; ++j) v[j] = w_o[(size_t)(k0 + j) * 1024 + n];
            v4u o; o.x = pg8::pkbf(v[0], v[1]); o.y = pg8::pkbf(v[2], v[3]); o.z = pg8::pkbf(v[4], v[5]); o.w = pg8::pkbf(v[6], v[7]);
            *(v4u*)(WTO + (size_t)n * 1024 + k0) = o;
        } else if (i < I_W + I_O + I_LB) {
            const int c = (int)(i - I_W - I_O);
            LB[c] = 1.0f / (1.0f + expf(lbl[512 + c] - lbl[c]));
        } else {
            const long ii = i - I_W - I_O - I_LB;
            const f32x4 p = ((const f32x4*)x)[2 * ii], q = ((const f32x4*)x)[2 * ii + 1];
            v4u o; o.x = pg8::pkbf(p[0], p[1]); o.y = pg8::pkbf(p[2], p[3]); o.z = pg8::pkbf(q[0], q[1]); o.w = pg8::pkbf(q[2], q[3]);
            ((v4u*)XB)[ii] = o;
        }
    }
}
#define GAS __attribute__((address_space(1)))
#define LAS __attribute__((address_space(3)))
typedef GAS unsigned gu32;
#define RLX_AGENT __ATOMIC_RELAXED, __HIP_MEMORY_SCOPE_AGENT

#define XB_TMO      128
#define XB_XCNT(j)  (256  + 64 * (j))
#define XB_XSUB(j)  (1280 + 64 * (j))
#define XB_XGEN(j)  (2304 + 64 * (j))
#define XB_TOP      3328
#define XB_TOPGEN   3392
#define XCD_BAR_WORDS 3456
#define XB_SPIN_CAP (1u << 18)

__device__ __forceinline__ unsigned xb_ld(unsigned* p)              { return __hip_atomic_load(p, __ATOMIC_RELAXED, __HIP_MEMORY_SCOPE_AGENT); }
__device__ __forceinline__ unsigned xb_add(unsigned* p, unsigned v) { return __hip_atomic_fetch_add(p, v, __ATOMIC_RELAXED, __HIP_MEMORY_SCOPE_AGENT); }
__device__ __forceinline__ unsigned xb_xcc_id() { return (unsigned)__builtin_amdgcn_s_getreg((3 << 11) | 20) & 0xFu; }
#define XB_SPIN(cond, bar) do { unsigned _sp = 0; while (cond) { __builtin_amdgcn_s_sleep(1); \
    if ((++_sp & 255u) == 0u) { if (xb_ld(&(bar)[XB_TMO])) break; if (_sp > XB_SPIN_CAP) { atomicAdd(&(bar)[XB_TMO], 1u); break; } } } } while (0)

struct XcdBarrier {
    unsigned* bar; unsigned x;
    volatile LAS unsigned* st;
};

__device__ __forceinline__ XcdBarrier xcd_barrier_post(unsigned* bar, volatile LAS unsigned* st) {
    XcdBarrier b; b.bar = bar; b.x = xb_xcc_id(); b.st = st;
    if (threadIdx.x == 0) (void)xb_add(&bar[XB_XCNT(b.x)], 1u);
    return b;
}
__device__ __forceinline__ void xcd_barrier_complete(unsigned* bar, unsigned x, unsigned& nloc, unsigned& nx) {
    const unsigned G = gridDim.x * gridDim.y * gridDim.z;
    unsigned sum, cnt, mine, sp = 0u;
    for (;;) {
        sum = 0u; cnt = 0u; mine = 0u;
#pragma unroll
        for (unsigned j = 0; j < 16; ++j) { const unsigned c = xb_ld(&bar[XB_XCNT(j)]); sum += c; cnt += (c > 0u) ? 1u : 0u; mine = (j == x) ? c : mine; }
        if (sum == G) break;
        __builtin_amdgcn_s_sleep(1);
        if ((++sp & 255u) == 0u) { if (xb_ld(&bar[XB_TMO])) break; if (sp > XB_SPIN_CAP) { atomicAdd(&bar[XB_TMO], 1u); break; } }
    }
    nloc = mine > 0u ? mine : 1u; nx = cnt > 0u ? cnt : 1u;
}

__device__ __forceinline__ void xcd_barrier(const XcdBarrier& b) {
    asm volatile("s_waitcnt vmcnt(0)" ::: "memory");
    __syncthreads();
    if (threadIdx.x == 0) {
        unsigned* bar = b.bar;
        __builtin_amdgcn_s_waitcnt(0);
        unsigned nloc = b.st[0], nx = b.st[1];
        if (nloc == 0u) { xcd_barrier_complete(bar, b.x, nloc, nx); b.st[0] = nloc; b.st[1] = nx; }
        const unsigned old = xb_add(&bar[XB_XSUB(b.x)], 1u);
        const unsigned gen = old / nloc;
        if (old + 1u == (gen + 1u) * nloc) {
            __builtin_amdgcn_fence(__ATOMIC_RELEASE, "agent");
            asm volatile("s_waitcnt vmcnt(0)" ::: "memory");
            const unsigned og = xb_add(&bar[XB_TOP], 1u);
            const unsigned tg = og / nx;
            if (og + 1u == (tg + 1u) * nx) xb_add(&bar[XB_TOPGEN], 1u);
            else XB_SPIN(xb_ld(&bar[XB_TOPGEN]) == tg, bar);
            __builtin_amdgcn_fence(__ATOMIC_ACQUIRE, "agent");
            xb_add(&bar[XB_XGEN(b.x)], 1u);
            asm volatile("s_waitcnt vmcnt(0)" ::: "memory");
        } else {
            XB_SPIN(xb_ld(&bar[XB_XGEN(b.x)]) == gen, bar);
            __builtin_amdgcn_fence(__ATOMIC_ACQUIRE, "agent");
            asm volatile("s_waitcnt vmcnt(0)" ::: "memory");
        }
    }
    __syncthreads();
}


constexpr int NTHR = 512;
constexpr int LDS_BYTES = 155648;

__device__ __forceinline__ void ph_gemm_in(const Args& a, unsigned char* lds) {
    pg8::Gemm g{(const pg8::bf16_t*)(a.ws + WS_XB), (const pg8::bf16_t*)(a.ws + WS_WTIN), T_TOK, NPROJ, DM};
    pg8::StaticOrder S; S.init(T_TOK, NPROJ, (int)gridDim.x, (int)blockIdx.x); S.rep = PG8_REPEAT;
    pg8::EpiInProj E{(unsigned short*)(a.ws + WS_H16), (float*)(a.ws + WS_MISC), (const float*)(a.ws + WS_LB), H16_STRIDE};
    pg8::gemm_phase<pg8::EpiInProj, pg8::StaticOrder, true, true>((PG8_LAS unsigned char*)lds, g, S, E);
}
__device__ __forceinline__ void ph_gemm_out(const Args& a, unsigned char* lds) {
    pg8::Gemm g{(const pg8::bf16_t*)(a.ws + WS_MIX), (const pg8::bf16_t*)(a.ws + WS_WTO), T_TOK, DM, DM};
    pg8::StaticOrder S; S.init(T_TOK, DM, (int)gridDim.x, (int)blockIdx.x);
    pg8::EpiOutRes E{a.in[0], a.out, DN_ALPHA};
    pg8::gemm_phase<pg8::EpiOutRes, pg8::StaticOrder, true, true>((PG8_LAS unsigned char*)lds, g, S, E);
}

__device__ __forceinline__ void ph_post(const Args& a) {
    const float* misc = (const float*)(a.ws + WS_MISC); const float* kvg = a.in[4];
    bf16* CN = (bf16*)(a.ws + WS_CN); bf16* IKB = (bf16*)(a.ws + WS_IKB); float* IWF = (float*)(a.ws + WS_IWF);
    const int lane = threadIdx.x & 63, gw = (blockIdx.x * NTHR + threadIdx.x) >> 6, ngw = (gridDim.x * NTHR) >> 6;
    for (int t = gw; t < T_TOK; t += ngw) {
        const float* row = misc + (size_t)t * 256;
        const float c0 = row[2 * lane], c1 = row[2 * lane + 1];
        const float ms = wave_sum(c0 * c0 + c1 * c1) * (1.0f / 128.0f);
        const float rs = 1.0f / sqrtf(ms + 1e-6f);
        ((unsigned*)CN)[(size_t)t * 64 + lane] = pg8::pkbf(c0 * rs * kvg[2 * lane], c1 * rs * kvg[2 * lane + 1]);
        const float k0 = row[128 + lane]; const float k1 = __shfl_xor(k0, 1);
        if ((lane & 1) == 0) ((unsigned*)IKB)[(size_t)t * 32 + (lane >> 1)] = pg8::pkbf(k0, k1);
        if (lane < 8) IWF[(size_t)t * 8 + lane] = row[192 + lane] * IW_SCALE;
    }
}

typedef short hbf16x8 __attribute__((ext_vector_type(8)));
typedef float hf32x4 __attribute__((ext_vector_type(4)));
constexpr int HG_QP = 272, HG_SP = 144;
constexpr int HL_QT = 0, HL_KT = 17408, HL_KTT = 34816, HL_VT = 53248, HL_P = 57856, HL_SST = 67072, HL_PART = 75776, HL_BM = 77824, HL_BL = 78336, HL_END = 78848;
__device__ __forceinline__ void ph_hgrn(const Args& a, unsigned char* lds) {
    const bf16* BQ = (const bf16*)(a.ws + WS_H16) + 3 * H16_STRIDE; const bf16* BF = (const bf16*)(a.ws + WS_H16) + 4 * H16_STRIDE; const bf16* BI = (const bf16*)(a.ws + WS_H16) + 5 * H16_STRIDE;
    float* OB = (float*)(a.ws + WS_OB);
    const int tid = threadIdx.x, lane = tid & 63, w = tid >> 6, fr = lane & 15, fq = lane >> 4;
    const int k = tid & 127, tq = tid >> 7;
    const int vs_s = tid >> 3, vs_v = (tid & 7) * 4;
    float* part = (float*)(lds + HL_PART); float* bmv = (float*)(lds + HL_BM); float* blv = (float*)(lds + HL_BL);
    for (int item = blockIdx.x; item < NBATCH * 4 * 4; item += gridDim.x) {
        const int b = item >> 4, h = (item >> 2) & 3, vs = item & 3;
        const size_t colq = (size_t)h * 128 + k, colv = (size_t)h * 128 + vs * 32;
        hf32x4 st[2]; st[0] = (hf32x4){0.f, 0.f, 0.f, 0.f}; st[1] = st[0];
        unsigned short gq[16], gf[16]; unsigned long long gv;
        { const size_t tb = (size_t)b * SEQ;
#pragma unroll
          for (int i = 0; i < 16; ++i) { const size_t off = (tb + 16 * tq + i) * 512 + colq; gq[i] = BQ[off]; gf[i] = BF[off]; }
          gv = *(const unsigned long long*)(BI + (tb + vs_s) * 512 + colv + vs_v); }
        for (int n = 0; n < SEQ / 64; ++n) {
            const size_t tb = (size_t)b * SEQ + 64 * n;
            float g[16], c[16]; float run = 0.f;
#pragma unroll
            for (int i = 0; i < 16; ++i) { g[i] = h2f(gf[i]); run += g[i]; c[i] = run; }
            part[tq * 128 + k] = run;
            __syncthreads();
            const float p0 = part[k], p1 = part[128 + k], p2 = part[256 + k], p3 = part[384 + k];
            const float bm = p0 + p1, bl = (p0 + p1) + (p2 + p3);
            const float offs = tq == 0 ? 0.f : tq == 1 ? p0 : tq == 2 ? (p0 + p1) : (p0 + p1) + p2;
            if (tq == 0) { bmv[k] = bm; blv[k] = bl; }
            unsigned short qt[16], kt[16];
#pragma unroll
            for (int i = 0; i < 16; ++i) {
                const float B = offs + c[i];
                const float eq = __builtin_amdgcn_exp2f(fminf(B - bm, 80.f) * LOG2E), ek = __builtin_amdgcn_exp2f(fminf(bm - B, 80.f) * LOG2E);
                const float kk = 1.0f - __builtin_amdgcn_exp2f(g[i] * LOG2E);
                qt[i] = (unsigned short)(pg8::pkbf(bf2f(gq[i]) * eq, 0.f) & 0xffffu); kt[i] = (unsigned short)(pg8::pkbf(kk * ek, 0.f) & 0xffffu);
            }
#pragma unroll
            for (int i = 0; i < 16; ++i) { *(unsigned short*)(lds + HL_QT + (16 * tq + i) * HG_QP + 2 * k) = qt[i]; *(unsigned short*)(lds + HL_KT + (16 * tq + i) * HG_QP + 2 * k) = kt[i]; }
            { v4u w0, w1;
              w0.x = kt[0] | ((unsigned)kt[1] << 16); w0.y = kt[2] | ((unsigned)kt[3] << 16); w0.z = kt[4] | ((unsigned)kt[5] << 16); w0.w = kt[6] | ((unsigned)kt[7] << 16);
              w1.x = kt[8] | ((unsigned)kt[9] << 16); w1.y = kt[10] | ((unsigned)kt[11] << 16); w1.z = kt[12] | ((unsigned)kt[13] << 16); w1.w = kt[14] | ((unsigned)kt[15] << 16);
              *(v4u*)(lds + HL_KTT + k * HG_SP + 32 * tq) = w0; *(v4u*)(lds + HL_KTT + k * HG_SP + 32 * tq + 16) = w1; }
            { *(unsigned short*)(lds + HL_VT + (vs_v + 0) * HG_SP + 2 * vs_s) = (unsigned short)(gv & 0xffffu); *(unsigned short*)(lds + HL_VT + (vs_v + 1) * HG_SP + 2 * vs_s) = (unsigned short)((gv >> 16) & 0xffffu);
              *(unsigned short*)(lds + HL_VT + (vs_v + 2) * HG_SP + 2 * vs_s) = (unsigned short)((gv >> 32) & 0xffffu); *(unsigned short*)(lds + HL_VT + (vs_v + 3) * HG_SP + 2 * vs_s) = (unsigned short)(gv >> 48); }
            if (n + 1 < SEQ / 64) { const size_t tn = tb + 64;
#pragma unroll
                for (int i = 0; i < 16; ++i) { const size_t off = (tn + 16 * tq + i) * 512 + colq; gq[i] = BQ[off]; gf[i] = BF[off]; }
                gv = *(const unsigned long long*)(BI + (tn + vs_s) * 512 + colv + vs_v); }
            __syncthreads();
#pragma unroll
            for (int j = 0; j < 2; ++j) {
                const int ti = 2 * w + j, kb = ti >> 1, vb = ti & 1, kr = 16 * kb + 4 * fq;
                const hf32x4 bm4 = *(const hf32x4*)(bmv + kr), bl4 = *(const hf32x4*)(blv + kr);
                { uint2 o; o.x = pg8::pkbf(st[j][0] * __builtin_amdgcn_exp2f(bm4[0] * LOG2E), st[j][1] * __builtin_amdgcn_exp2f(bm4[1] * LOG2E));
                  o.y = pg8::pkbf(st[j][2] * __builtin_amdgcn_exp2f(bm4[2] * LOG2E), st[j][3] * __builtin_amdgcn_exp2f(bm4[3] * LOG2E));
                  *(uint2*)(lds + HL_SST + (16 * vb + fr) * HG_QP + 2 * kr) = o; }
                hf32x4 kv = (hf32x4){0.f, 0.f, 0.f, 0.f};
#pragma unroll
                for (int ks = 0; ks < 2; ++ks) {
                    const hbf16x8 af = *(const hbf16x8*)(lds + HL_KTT + (16 * kb + fr) * HG_SP + (32 * ks + 8 * fq) * 2);
                    const hbf16x8 bfr = *(const hbf16x8*)(lds + HL_VT + (16 * vb + fr) * HG_SP + (32 * ks + 8 * fq) * 2);
                    kv = __builtin_amdgcn_mfma_f32_16x16x32_bf16(af, bfr, kv, 0, 0, 0);
                }
#pragma unroll
                for (int r = 0; r < 4; ++r) st[j][r] = st[j][r] * __builtin_amdgcn_exp2f(bl4[r] * LOG2E) + kv[r] * __builtin_amdgcn_exp2f((bl4[r] - bm4[r]) * LOG2E);
                const int sb = ti >> 2, tk = ti & 3;
                hf32x4 sc = (hf32x4){0.f, 0.f, 0.f, 0.f};
                if (tk >= sb) {
#pragma unroll
                    for (int ks = 0; ks < 4; ++ks) {
                        const hbf16x8 af = *(const hbf16x8*)(lds + HL_KT + (16 * sb + fr) * HG_QP + (32 * ks + 8 * fq) * 2);
                        const hbf16x8 bfr = *(const hbf16x8*)(lds + HL_QT + (16 * tk + fr) * HG_QP + (32 * ks + 8 * fq) * 2);
                        sc = __builtin_amdgcn_mfma_f32_16x16x32_bf16(af, bfr, sc, 0, 0, 0);
                    }
                    if (tk == sb) {
#pragma unroll
                        for (int r = 0; r < 4; ++r) if (4 * fq + r > fr) sc[r] = 0.f;
                    }
                }
                { uint2 o; o.x = pg8::pkbf(sc[0], sc[1]); o.y = pg8::pkbf(sc[2], sc[3]); *(uint2*)(lds + HL_P + (16 * tk + fr) * HG_SP + (16 * sb + 4 * fq) * 2) = o; }
            }
            __syncthreads();
            { const int vb2 = w & 1, tk2 = w >> 1; hf32x4 o = (hf32x4){0.f, 0.f, 0.f, 0.f};
#pragma unroll
              for (int ks = 0; ks < 2; ++ks) {
                  const hbf16x8 af = *(const hbf16x8*)(lds + HL_VT + (16 * vb2 + fr) * HG_SP + (32 * ks + 8 * fq) * 2);
                  const hbf16x8 bfr = *(const hbf16x8*)(lds + HL_P + (16 * tk2 + fr) * HG_SP + (32 * ks + 8 * fq) * 2);
                  o = __builtin_amdgcn_mfma_f32_16x16x32_bf16(af, bfr, o, 0, 0, 0);
              }
#pragma unroll
              for (int ks = 0; ks < 4; ++ks) {
                  const hbf16x8 af = *(const hbf16x8*)(lds + HL_SST + (16 * vb2 + fr) * HG_QP + (32 * ks + 8 * fq) * 2);
                  const hbf16x8 bfr = *(const hbf16x8*)(lds + HL_QT + (16 * tk2 + fr) * HG_QP + (32 * ks + 8 * fq) * 2);
                  o = __builtin_amdgcn_mfma_f32_16x16x32_bf16(af, bfr, o, 0, 0, 0);
              }
              *(hf32x4*)(OB + (tb + 16 * tk2 + fr) * 512 + colv + 16 * vb2 + 4 * fq) = o; }
        }
        __syncthreads();
    }
}

typedef float f32x16 __attribute__((ext_vector_type(16)));
typedef short s16x4 __attribute__((ext_vector_type(4)));
typedef short v4i16_t __attribute__((ext_vector_type(4)));
#define LAS __attribute__((address_space(3)))
constexpr int SC_PITCH = 2052;
constexpr int DL_SC = 0, DL_K0 = 0, DL_K1 = 16384, DL_MASK = 16 * SC_PITCH * 4  , DL_BTAB = DL_MASK + 16384  , DL_END = DL_BTAB + 4 * 320 * 4  ;
constexpr float SM_THR = 4.0f;

__device__ __forceinline__ int t5_bucket(int rel) {
    const int n = rel < 0 ? -rel : rel; int bk;
    if (n < 8) bk = n; else bk = 8 + (n >= 13) + (n >= 20) + (n >= 30) + (n >= 46) + (n >= 70) + (n >= 108) + (n >= 166);
    return bk + (rel > 0 ? 16 : 0);
}
__device__ __forceinline__ int fkey(float f) { const int b = __float_as_int(f); return b ^ ((b >> 31) & 0x7fffffff); }
__device__ __forceinline__ unsigned koff(unsigned row, unsigned ch) { return 256u * row + 16u * (ch ^ (((row & 3u) << 2) | ((row >> 2) & 3u))); }
__device__ __forceinline__ float xhalf(float v) { return __shfl_xor(v, 32); }

template <int NREG> __device__ __forceinline__ void select_q(const LAS float* row, int nreg, LAS unsigned long long* mrow, int lane) {
    int v[NREG];
#pragma unroll
    for (int j = 0; j < NREG; ++j) v[j] = (j < nreg) ? fkey(row[64 * j + lane]) : (int)0x80000000;
    long long lo = (long long)(int)0x80000000, hi = 0x7fffffffLL; int thr = 0, cnt_hi = 0; bool exact = false;
    for (;;) {
        if (hi - lo <= 1) break;
        const int mid = (int)(lo + (hi - lo) / 2); int cnt = 0;
#pragma unroll
        for (int j = 0; j < NREG; ++j) cnt += __builtin_popcountll(__ballot(v[j] > mid));
        if (cnt == 256) { thr = mid; exact = true; break; }
        if (cnt > 256) lo = mid; else { hi = mid; cnt_hi = cnt; }
    }
    unsigned long long mine = 0ull;
    if (exact) {
#pragma unroll
        for (int j = 0; j < NREG; ++j) { const unsigned long long bal = __ballot(v[j] > thr); if (lane == j) mine = bal; }
    } else {
        const int vk = (int)hi; int before = 0; const int need = 256 - cnt_hi;
        const unsigned long long ltmask = (1ull << lane) - 1ull;
#pragma unroll
        for (int j = 0; j < NREG; ++j) {
            const unsigned long long eqm = __ballot(v[j] == vk);
            const int rank = before + __builtin_popcountll(eqm & ltmask);
            const bool s = (v[j] > vk) || (v[j] == vk && rank < need);
            const unsigned long long bal = __ballot(s); before += __builtin_popcountll(eqm);
            if (lane == j) mine = bal;
        }
    }
    if (lane < 32) mrow[lane] = mine;
}

__device__ __forceinline__ void ph_mixb(const Args& a) {
    const float* OB = (const float*)(a.ws + WS_OB); const float* hg = a.in[7];
    const bf16* BG = (const bf16*)(a.ws + WS_H16) + 6 * H16_STRIDE; bf16* MIX = (bf16*)(a.ws + WS_MIX);
    const int lane = threadIdx.x & 63, gw = (blockIdx.x * NTHR + threadIdx.x) >> 6, ngw = (gridDim.x * NTHR) >> 6;
    const f32x4 g0 = ((const f32x4*)hg)[2 * lane], g1 = ((const f32x4*)hg)[2 * lane + 1];
    for (int t = gw; t < T_TOK; t += ngw) {
        const f32x4 x0 = ((const f32x4*)(OB + (size_t)t * 512))[2 * lane], x1 = ((const f32x4*)(OB + (size_t)t * 512))[2 * lane + 1];
        const v4u gb = ((const v4u*)(BG + (size_t)t * 512))[lane];
        float ss = (x0[0] * x0[0] + x0[1] * x0[1]) + (x0[2] * x0[2] + x0[3] * x0[3]) + (x1[0] * x1[0] + x1[1] * x1[1]) + (x1[2] * x1[2] + x1[3] * x1[3]);
        ss += __shfl_xor(ss, 1); ss += __shfl_xor(ss, 2); ss += __shfl_xor(ss, 4); ss += __shfl_xor(ss, 8);
        const float rs = 1.0f / sqrtf(ss * (1.0f / 128.0f) + 1e-6f);
        v4u o;
        o.x = pg8::pkbf(x0[0] * rs * g0[0] * __uint_as_float(gb.x << 16), x0[1] * rs * g0[1] * __uint_as_float(gb.x & 0xffff0000u));
        o.y = pg8::pkbf(x0[2] * rs * g0[2] * __uint_as_float(gb.y << 16), x0[3] * rs * g0[3] * __uint_as_float(gb.y & 0xffff0000u));
        o.z = pg8::pkbf(x1[0] * rs * g1[0] * __uint_as_float(gb.z << 16), x1[1] * rs * g1[1] * __uint_as_float(gb.z & 0xffff0000u));
        o.w = pg8::pkbf(x1[2] * rs * g1[2] * __uint_as_float(gb.w << 16), x1[3] * rs * g1[3] * __uint_as_float(gb.w & 0xffff0000u));
        ((v4u*)(MIX + (size_t)t * 1024 + 512))[lane] = o;
    }
}

__device__ __forceinline__ void ph_dsa(const Args& a, unsigned char* lds_g) {
    const bf16* QL = (const bf16*)(a.ws + WS_H16); const bf16* IQ = (const bf16*)(a.ws + WS_H16) + 1 * H16_STRIDE; const bf16* AG = (const bf16*)(a.ws + WS_H16) + 2 * H16_STRIDE;
    const bf16* CN = (const bf16*)(a.ws + WS_CN); const bf16* IKB = (const bf16*)(a.ws + WS_IKB); const float* IWF = (const float*)(a.ws + WS_IWF);
    const bf16* WUVP = (const bf16*)(a.ws + WS_WUVP); const float* rel_bias = a.in[5]; bf16* MIX = (bf16*)(a.ws + WS_MIX);
    LAS unsigned char* lds = (LAS unsigned char*)lds_g;
    const int tid = threadIdx.x, lane = tid & 63, w = __builtin_amdgcn_readfirstlane(tid >> 6);
    LAS float* btab = (LAS float*)(lds + DL_BTAB);
    for (int i = tid; i < 4 * 320; i += NTHR) { const int h = i / 320, ii = i - h * 320; btab[i] = (ii < 319) ? LOG2E * rel_bias[t5_bucket(ii - 255) * 4 + h] : 0.f; }
    const int bx = blockIdx.x, bat = (bx & 7) * 2 + ((bx >> 3) >> 4), pr = (bx >> 3) & 15;
    if (gridDim.x != 256) return;
    const int ql = lane & 31, hi = lane >> 5, hd = w & 3, rg = w >> 2;
    const unsigned xr = ((ql & 3) << 2) | ((ql >> 2) & 3);
    unsigned arow[8];
#pragma unroll
    for (int s = 0; s < 8; ++s) arow[s] = 256u * ql + 16u * ((unsigned)(2 * s + hi) ^ xr);
    const unsigned q4 = (lane & 15) >> 2, p4 = lane & 3, blk = (lane >> 4) & 1, l2 = 2 * blk + (p4 >> 1);
    unsigned vadr[2][4];
#pragma unroll
    for (int t = 0; t < 2; ++t)
#pragma unroll
        for (int c4 = 0; c4 < 4; ++c4) vadr[t][c4] = 256u * (8 * t + 4 * hi + q4) + 64u * ((unsigned)c4 ^ q4) + 16u * (l2 ^ (unsigned)((2 * t + hi) & 3)) + 8u * (p4 & 1);
    const float cbias = LOG2E * rel_bias[15 * 4 + hd];
    const int fr = lane & 15, fq = lane >> 4;

#ifndef DSA_NCC
#define DSA_NCC 2
#endif
    for (int cc = 0; cc < DSA_NCC; ++cc) {
        const int c = (cc & 1) == 0 ? 31 - pr : pr, nk = 64 * (c + 1);
        const size_t tok0 = (size_t)bat * SEQ + 64 * c;
        const size_t key0 = (size_t)bat * SEQ;
        __syncthreads();
        LAS unsigned long long* mask = (LAS unsigned long long*)(lds + DL_MASK);
        if (c <= 3) {
            for (int i = tid; i < 64 * 32; i += NTHR) mask[i] = ((i & 31) <= c) ? ~0ull : 0ull;
        } else {
            for (int sub = 0; sub < 4; ++sub) {
                const size_t tq = tok0 + 16 * sub + fr;
                pg8::bf16x8 iqf[8][2];
#pragma unroll
                for (int h = 0; h < 8; ++h)
#pragma unroll
                    for (int ks = 0; ks < 2; ++ks) iqf[h][ks] = *(const pg8::bf16x8*)(IQ + tq * 512 + h * 64 + 32 * ks + 8 * fq);
                const f32x4 wv0 = *(const f32x4*)(IWF + tq * 8), wv1 = *(const f32x4*)(IWF + tq * 8 + 4);
                LAS float* sc = (LAS float*)(lds + DL_SC);
                for (int kt = w; kt < nk / 16; kt += 8) {
                    const bf16* kp = IKB + (key0 + 16 * kt + fr) * 64 + 8 * fq;
                    const pg8::bf16x8 k0 = *(const pg8::bf16x8*)kp, k1 = *(const pg8::bf16x8*)(kp + 32);
                    f32x4 s4 = (f32x4){0.f, 0.f, 0.f, 0.f};
#pragma unroll
                    for (int h = 0; h < 8; ++h) {
                        f32x4 acc = (f32x4){0.f, 0.f, 0.f, 0.f};
                        acc = __builtin_amdgcn_mfma_f32_16x16x32_bf16(k0, iqf[h][0], acc, 0, 0, 0);
                        acc = __builtin_amdgcn_mfma_f32_16x16x32_bf16(k1, iqf[h][1], acc, 0, 0, 0);
                        const float wh = h < 4 ? wv0[h & 3] : wv1[h & 3];
#pragma unroll
                        for (int r = 0; r < 4; ++r) s4[r] += wh * fmaxf(acc[r], 0.f);
                    }
#pragma unroll
                    for (int r = 0; r < 4; ++r) s4[r] += 0.0f;
                    *(LAS f32x4*)(sc + fr * SC_PITCH + 16 * kt + 4 * fq) = s4;
                }
                __syncthreads();
#pragma unroll 1
                for (int qi = 0; qi < 2; ++qi) {
                    const int qq = 2 * w + qi; const LAS float* row = sc + qq * SC_PITCH; LAS unsigned long long* mrow = mask + (16 * sub + qq) * 32;
                    if (c < 8) select_q<8>(row, c + 1, mrow, lane); else if (c < 16) select_q<16>(row, c + 1, mrow, lane); else if (c < 24) select_q<24>(row, c + 1, mrow, lane); else select_q<32>(row, c + 1, mrow, lane);
                }
                __syncthreads();
            }
        }
        const size_t tqa = tok0 + 32 * rg + ql;
        pg8::bf16x8 qf[8];
#pragma unroll
        for (int s = 0; s < 8; ++s) qf[s] = *(const pg8::bf16x8*)(QL + tqa * 512 + hd * 128 + 16 * s + 8 * hi);
        f32x16 o[4];
#pragma unroll
        for (int c4 = 0; c4 < 4; ++c4)
#pragma unroll
            for (int r = 0; r < 16; ++r) o[c4][r] = 0.f;
        float m_used = -1e30f, l_run = 0.f;
        const int lr0 = tid >> 4, lch = tid & 15;
        v4u kreg0, kreg1;
        { const bf16* src = CN + (key0 + lr0) * 128 + lch * 8; kreg0 = *(const v4u*)src; kreg1 = *(const v4u*)(src + 32 * 128); }
        *(LAS v4u*)(lds + DL_K0 + koff(lr0, lch)) = kreg0; *(LAS v4u*)(lds + DL_K0 + koff(lr0 + 32, lch)) = kreg1;
        const LAS unsigned long long* mq = mask + (32 * rg + ql) * 32;
        for (int j = 0; j <= c; ++j) {
            const unsigned kb_off = (j & 1) ? DL_K1 : DL_K0, nb_off = (j & 1) ? DL_K0 : DL_K1;
            __syncthreads();
            if (j < c) { const bf16* src = CN + (key0 + 64 * (j + 1) + lr0) * 128 + lch * 8; kreg0 = *(const v4u*)src; kreg1 = *(const v4u*)(src + 32 * 128); }
            const bool nearb = (j >= c - 3);
            f32x16 p0, p1;
            { const float ini = nearb ? 0.f : cbias;
#pragma unroll
              for (int r = 0; r < 16; ++r) { p0[r] = ini; p1[r] = ini; } }
#pragma unroll
            for (int s = 0; s < 8; ++s) {
                const pg8::bf16x8 ka = *(const LAS pg8::bf16x8*)(lds + kb_off + arow[s]), kb = *(const LAS pg8::bf16x8*)(lds + kb_off + 8192 + arow[s]);
                p0 = __builtin_amdgcn_mfma_f32_32x32x16_bf16(ka, qf[s], p0, 0, 0, 0);
                p1 = __builtin_amdgcn_mfma_f32_32x32x16_bf16(kb, qf[s], p1, 0, 0, 0);
            }
            if (nearb) {
                const LAS float* bp = btab + hd * 320 + (64 * (j - c) - 32 * rg - ql + 4 * hi + 255);
#pragma unroll
                for (int r = 0; r < 16; ++r) { p0[r] += bp[(r & 3) + 8 * (r >> 2)]; p1[r] += bp[32 + (r & 3) + 8 * (r >> 2)]; }
            }
            float tmax = fmaxf(p0[0], p1[0]);
#pragma unroll
            for (int r = 1; r < 16; ++r) tmax = fmaxf(tmax, fmaxf(p0[r], p1[r]));
            tmax = fmaxf(tmax, xhalf(tmax));
            if (__any(tmax > m_used + SM_THR)) {
                const float mn = fmaxf(m_used, tmax), al = __builtin_amdgcn_exp2f(m_used - mn);
#pragma unroll
                for (int c4 = 0; c4 < 4; ++c4)
#pragma unroll
                    for (int r = 0; r < 16; ++r) o[c4][r] *= al;
                l_run *= al; m_used = mn;
            }
            const unsigned long long mw = mq[j];
            const int m0 = (int)((unsigned)mw >> (4 * hi)), m1 = (int)((unsigned)(mw >> 32) >> (4 * hi));
#pragma unroll
            for (int r = 0; r < 16; ++r) {
                const int pos = (r & 3) + 8 * (r >> 2);
                const float e0 = __int_as_float(__float_as_int(__builtin_amdgcn_exp2f(p0[r] - m_used)) & __builtin_amdgcn_sbfe(m0, pos, 1));
                const float e1 = __int_as_float(__float_as_int(__builtin_amdgcn_exp2f(p1[r] - m_used)) & __builtin_amdgcn_sbfe(m1, pos, 1));
                l_run += e0 + e1; p0[r] = e0; p1[r] = e1;
            }
            pg8::bf16x8 pf[2][2];
#pragma unroll
            for (int s = 0; s < 2; ++s) {
                v4u x0, x1;
                x0.x = pg8::pkbf(p0[8 * s + 0], p0[8 * s + 1]); x0.y = pg8::pkbf(p0[8 * s + 2], p0[8 * s + 3]); x0.z = pg8::pkbf(p0[8 * s + 4], p0[8 * s + 5]); x0.w = pg8::pkbf(p0[8 * s + 6], p0[8 * s + 7]);
                x1.x = pg8::pkbf(p1[8 * s + 0], p1[8 * s + 1]); x1.y = pg8::pkbf(p1[8 * s + 2], p1[8 * s + 3]); x1.z = pg8::pkbf(p1[8 * s + 4], p1[8 * s + 5]); x1.w = pg8::pkbf(p1[8 * s + 6], p1[8 * s + 7]);
                pf[0][s] = __builtin_bit_cast(pg8::bf16x8, x0); pf[1][s] = __builtin_bit_cast(pg8::bf16x8, x1);
            }
#pragma unroll
            for (int kb = 0; kb < 2; ++kb)
#pragma unroll
                for (int s = 0; s < 2; ++s)
#pragma unroll
                    for (int c4 = 0; c4 < 4; ++c4) {
                        const s16x4 lo4 = __builtin_bit_cast(s16x4, __builtin_amdgcn_ds_read_tr16_b64_v4i16((LAS v4i16_t*)(lds + kb_off + 8192 * kb + 4096 * s + vadr[0][c4])));
                        const s16x4 hi4 = __builtin_bit_cast(s16x4, __builtin_amdgcn_ds_read_tr16_b64_v4i16((LAS v4i16_t*)(lds + kb_off + 8192 * kb + 4096 * s + vadr[1][c4])));
                        const pg8::bf16x8 vf = __builtin_shufflevector(lo4, hi4, 0, 1, 2, 3, 4, 5, 6, 7);
                        o[c4] = __builtin_amdgcn_mfma_f32_32x32x16_bf16(vf, pf[kb][s], o[c4], 0, 0, 0);
                    }
            if (j < c) { *(LAS v4u*)(lds + nb_off + koff(lr0, lch)) = kreg0; *(LAS v4u*)(lds + nb_off + koff(lr0 + 32, lch)) = kreg1; }
        }
        const float linv = 1.0f / (l_run + xhalf(l_run));
        pg8::bf16x8 of[4][2];
#pragma unroll
        for (int rb = 0; rb < 4; ++rb)
#pragma unroll
            for (int s = 0; s < 2; ++s) { v4u x;
                x.x = pg8::pkbf(o[rb][8 * s + 0] * linv, o[rb][8 * s + 1] * linv); x.y = pg8::pkbf(o[rb][8 * s + 2] * linv, o[rb][8 * s + 3] * linv);
                x.z = pg8::pkbf(o[rb][8 * s + 4] * linv, o[rb][8 * s + 5] * linv); x.w = pg8::pkbf(o[rb][8 * s + 6] * linv, o[rb][8 * s + 7] * linv);
                of[rb][s] = __builtin_bit_cast(pg8::bf16x8, x); }
#pragma unroll 1
        for (int vb = 0; vb < 4; ++vb) {
            f32x16 y;
#pragma unroll
            for (int r = 0; r < 16; ++r) y[r] = 0.f;
            const bf16* wp = WUVP + ((size_t)hd * 128 + 32 * vb + ql) * 128 + 8 * hi;
#pragma unroll
            for (int rb = 0; rb < 4; ++rb)
#pragma unroll
                for (int s = 0; s < 2; ++s) { const pg8::bf16x8 wf = *(const pg8::bf16x8*)(wp + 32 * rb + 16 * s); y = __builtin_amdgcn_mfma_f32_32x32x16_bf16(wf, of[rb][s], y, 0, 0, 0); }
#pragma unroll
            for (int g = 0; g < 4; ++g) {
                const size_t col = (size_t)hd * 128 + 32 * vb + 8 * g + 4 * hi;
                const uint2 gt = *(const uint2*)(AG + tqa * 512 + col);
                uint2 ov; ov.x = pg8::pkbf(y[4 * g + 0] * __uint_as_float(gt.x << 16), y[4 * g + 1] * __uint_as_float(gt.x & 0xffff0000u));
                ov.y = pg8::pkbf(y[4 * g + 2] * __uint_as_float(gt.y << 16), y[4 * g + 3] * __uint_as_float(gt.y & 0xffff0000u));
                *(uint2*)(MIX + tqa * 1024 + col) = ov;
            }
        }
    }
    __syncthreads();
}

__device__ __forceinline__ void ph_ln(const Args& a) {
    float* out = a.out; const float* g = a.in[9]; const float* bb = a.in[10];
    const int lane = threadIdx.x & 63, gw = (blockIdx.x * NTHR + threadIdx.x) >> 6, ngw = (gridDim.x * NTHR) >> 6;
    for (int t = gw; t < T_TOK; t += ngw) {
        f32x4* row = (f32x4*)(out + (size_t)t * 1024) + lane; f32x4 v[4]; float s = 0.f;
#pragma unroll
        for (int j = 0; j < 4; ++j) { v[j] = row[64 * j]; s += (v[j][0] + v[j][1]) + (v[j][2] + v[j][3]); }
        const float mean = wave_sum(s) * (1.0f / 1024.0f); float s2 = 0.f;
#pragma unroll
        for (int j = 0; j < 4; ++j) { v[j] = v[j] - mean; s2 += (v[j][0] * v[j][0] + v[j][1] * v[j][1]) + (v[j][2] * v[j][2] + v[j][3] * v[j][3]); }
        const float rstd = 1.0f / sqrtf(wave_sum(s2) * (1.0f / 1024.0f) + 1e-5f);
#pragma unroll
        for (int j = 0; j < 4; ++j) { const f32x4 gv = ((const f32x4*)g)[lane + 64 * j], bv = ((const f32x4*)bb)[lane + 64 * j]; row[64 * j] = v[j] * rstd * gv + bv; }
    }
}

#ifndef REP_PREP
#define REP_PREP 1
#endif
#ifndef REP_GIN
#define REP_GIN 1
#endif
#ifndef REP_HGRN
#define REP_HGRN 1
#endif
#ifndef REP_DSA
#define REP_DSA 1
#endif
#ifndef REP_GOUT
#define REP_GOUT 1
#endif
__global__ void __launch_bounds__(NTHR, 2) mk_fwd(Args a) {
    extern __shared__ __attribute__((aligned(16))) unsigned char lds[];
    if (threadIdx.x < 2) ((volatile LAS unsigned*)((LAS unsigned char*)lds + LDS_BYTES - 64))[threadIdx.x] = 0u;
    __syncthreads();
    XcdBarrier bar = xcd_barrier_post((unsigned*)(a.ws + WS_CTL) + 4096, (volatile LAS unsigned*)((LAS unsigned char*)lds + LDS_BYTES - 64));
    _Pragma("unroll 1") for (int rep = 0; rep < (a.ws ? REP_PREP : 1); ++rep) p0_prep(a, (long)blockIdx.x * NTHR + threadIdx.x, (long)gridDim.x * NTHR);
    xcd_barrier(bar);
    _Pragma("unroll 1") for (int rep = 0; rep < (a.ws ? REP_GIN : 1); ++rep) ph_gemm_in(a, lds);
    xcd_barrier(bar);
    ph_post(a);
    _Pragma("unroll 1") for (int rep = 0; rep < (a.ws ? REP_HGRN : 1); ++rep) ph_hgrn(a, lds);
    xcd_barrier(bar);
    ph_mixb(a);
    _Pragma("unroll 1") for (int rep = 0; rep < (a.ws ? REP_DSA : 1); ++rep) ph_dsa(a, lds);
    xcd_barrier(bar);
    _Pragma("unroll 1") for (int rep = 0; rep < (a.ws ? REP_GOUT : 1); ++rep) ph_gemm_out(a, lds);
    xcd_barrier(bar);
#ifdef EXTRA_SYNCS
    for (int i = 0; i < EXTRA_SYNCS; ++i) xcd_barrier(bar);
#endif
#ifdef EXTRA_LIGHT
    for (int i = 0; i < EXTRA_LIGHT; ++i) { ph_post(a); ph_mixb(a); }
    xcd_barrier(bar);
#endif
    ph_ln(a);
}

extern "C" void kernel_launch(void* const* d_in, const int* in_sizes, int n_in, void* d_out, int out_size, void* d_ws, size_t ws_size, hipStream_t stream) {
    static int grid = 0;
    if (grid == 0) {
        if (n_in != 11 || out_size != T_TOK * DM || ws_size < WS_END) { fprintf(stderr, "kernel_launch: unexpected shapes (n_in %d, out %d, ws %zu)\n", n_in, out_size, ws_size); grid = -1; return; }
        if (hipFuncSetAttribute((const void*)mk_fwd, hipFuncAttributeMaxDynamicSharedMemorySize, LDS_BYTES) != hipSuccess) { fprintf(stderr, "kernel_launch: hipFuncSetAttribute failed\n"); grid = -1; return; }
        int dev = 0, cus = 0, per_cu = 0;
        (void)hipGetDevice(&dev); (void)hipDeviceGetAttribute(&cus, hipDeviceAttributeMultiprocessorCount, dev);
        (void)hipOccupancyMaxActiveBlocksPerMultiprocessor(&per_cu, (const void*)mk_fwd, NTHR, LDS_BYTES);
        if (per_cu < 1 || cus < 1) { fprintf(stderr, "kernel_launch: occupancy query says %d blocks/CU on %d CUs\n", per_cu, cus); grid = -1; return; }
        grid = cus;
        fprintf(stderr, "kernel_launch: %d CUs, %d blocks/CU by the occupancy query, grid %d\n", cus, per_cu, grid);
    }
    if (grid < 0) return;
    Args a{};
    for (int i = 0; i < 11; ++i) a.in[i] = (const float*)d_in[i];
    a.out = (float*)d_out; a.ws = (unsigned char*)d_ws;
    if (hipMemsetAsync((char*)d_ws + WS_CTL, 0, 65536, stream) != hipSuccess) { fprintf(stderr, "kernel_launch: hipMemsetAsync failed\n"); return; }
    hipLaunchKernelGGL(mk_fwd, dim3(grid), dim3(NTHR), LDS_BYTES, stream, a);
    const hipError_t e = hipPeekAtLastError();
    if (e != hipSuccess) fprintf(stderr, "kernel_launch: launch failed: %s (grid %d)\n", hipGetErrorName(e), grid);
}
```
